# Optimizing an MI355X kernel written in HIP

```python
import jax, jax.numpy as jnp
from jax import lax
import numpy as np

D_MODEL = 1024
BATCH = 2
SEQ = 8192
DEPTH = 2

GRID_W = 64
CTX_LEN = 256
N_MIXERS = 2
N_POOL_GROUPS = 4
POOL_WINDOWS = (2, 4, 8, 16)
POOL_GROUP_DIM = D_MODEL // N_POOL_GROUPS
HEAD_DIM = 128
N_Q_HEADS = D_MODEL // HEAD_DIM
N_KV_HEADS = 2
Q_PER_KV = N_Q_HEADS // N_KV_HEADS
QKV_DIM = (N_Q_HEADS + 2 * N_KV_HEADS) * HEAD_DIM
ROPE_THETA = 10000.0
Q_BLOCK = 128
D_FF = 4 * D_MODEL
N_MOD = 6
EPS = 1e-6
N_POOL_LAYERS = (DEPTH + 1) // 2
N_ATTN_LAYERS = DEPTH // 2

kernel_name = 'hybrid_pool_attn_dit_block'


def rms_norm(x, g):
    xf = x.astype(jnp.float32)
    y = xf * lax.rsqrt(jnp.mean(xf * xf, axis=-1, keepdims=True) + EPS)
    return (y * g.astype(jnp.float32)).astype(x.dtype)


def ada_mods(cond, w, b):
    m = (jax.nn.silu(cond) @ w + b)[..., None, :]
    return jnp.split(m, N_MOD, axis=-1)


def modulate(h, shift, scale):
    return h * (1.0 + scale) + shift


def pool_mixer(h, w_pool, pool_scale):
    B, L, D = h.shape
    t = jnp.arange(L)
    hf = h.astype(jnp.float32)
    cs = jnp.concatenate([jnp.zeros((B, 1, D), jnp.float32), jnp.cumsum(hf, axis=1)], axis=1)
    outs = []
    for g, w in enumerate(POOL_WINDOWS):
        sl = slice(g * POOL_GROUP_DIM, (g + 1) * POOL_GROUP_DIM)
        lo = jnp.clip(t - w // 2, 0, L)
        hi = jnp.clip(t + w - w // 2, 0, L)
        csg = cs[..., sl]
        cnt = (hi - lo).astype(jnp.float32)[:, None]
        mean = (jnp.take(csg, hi, axis=1) - jnp.take(csg, lo, axis=1)) / cnt
        diff = (mean - hf[..., sl]).astype(h.dtype)
        outs.append(diff @ w_pool[g])
    return jnp.concatenate(outs, axis=-1) * pool_scale


def axial_rope_tables(L):
    rows = L // GRID_W
    row = jnp.broadcast_to(jnp.arange(rows)[:, None], (rows, GRID_W)).reshape(L).astype(jnp.float32)
    col = jnp.broadcast_to(jnp.arange(GRID_W)[None, :], (rows, GRID_W)).reshape(L).astype(jnp.float32)
    half = HEAD_DIM // 2
    inv_freq = jnp.power(jnp.float32(ROPE_THETA), -jnp.arange(0, half, 2, dtype=jnp.float32) / half)
    ang_r = row[:, None] * inv_freq
    ang_c = col[:, None] * inv_freq
    return (jnp.cos(ang_r)[:, None, :], jnp.sin(ang_r)[:, None, :],
            jnp.cos(ang_c)[:, None, :], jnp.sin(ang_c)[:, None, :])


def _rotate(x, cos, sin):
    x1, x2 = jnp.split(x, 2, axis=-1)
    return jnp.concatenate([x1 * cos - x2 * sin, x2 * cos + x1 * sin], axis=-1)


def apply_axial_rope(x, tables):
    cr, sr, cc, sc = tables
    xf = x.astype(jnp.float32)
    half = HEAD_DIM // 2
    out = jnp.concatenate([_rotate(xf[..., :half], cr, sr), _rotate(xf[..., half:], cc, sc)], axis=-1)
    return out.astype(x.dtype)


def qkv_project(h, w_qkv, g_q, g_k):
    B, L, _ = h.shape
    qkv = h @ w_qkv
    q = qkv[..., :N_Q_HEADS * HEAD_DIM].reshape(B, L, N_Q_HEADS, HEAD_DIM)
    k = qkv[..., N_Q_HEADS * HEAD_DIM:(N_Q_HEADS + N_KV_HEADS) * HEAD_DIM].reshape(B, L, N_KV_HEADS, HEAD_DIM)
    v = qkv[..., (N_Q_HEADS + N_KV_HEADS) * HEAD_DIM:].reshape(B, L, N_KV_HEADS, HEAD_DIM)
    return rms_norm(q, g_q), rms_norm(k, g_k), v


def attend(q, k, v):
    s = jnp.einsum('bqhgd,bkhd->bhgqk', q, k).astype(jnp.float32) * (HEAD_DIM ** -0.5)
    p = jax.nn.softmax(s, axis=-1).astype(v.dtype)
    return jnp.einsum('bhgqk,bkhd->bqhgd', p, v)


def attention_mixer(h_lat, h_ctx, w_qkv, g_q, g_k, w_o, need_ctx_out):
    B, L, D = h_lat.shape
    C = h_ctx.shape[1]
    tables = axial_rope_tables(L)
    q_l, k_l, v_l = qkv_project(h_lat, w_qkv, g_q, g_k)
    q_l = apply_axial_rope(q_l, tables)
    k_l = apply_axial_rope(k_l, tables)
    q_c, k_c, v_c = qkv_project(h_ctx, w_qkv, g_q, g_k)
    k_all = jnp.concatenate([k_c, k_l], axis=1)
    v_all = jnp.concatenate([v_c, v_l], axis=1)
    nb = L // Q_BLOCK
    qb = q_l.reshape(B, nb, Q_BLOCK, N_KV_HEADS, Q_PER_KV, HEAD_DIM).transpose(1, 0, 2, 3, 4, 5)
    o_blocks = lax.map(lambda qblk: attend(qblk, k_all, v_all), qb)
    o_lat = o_blocks.transpose(1, 0, 2, 3, 4, 5).reshape(B, L, D) @ w_o
    o_ctx = None
    if need_ctx_out:
        qc = q_c.reshape(B, C, N_KV_HEADS, Q_PER_KV, HEAD_DIM)
        o_ctx = attend(qc, k_c, v_c).reshape(B, C, D) @ w_o
    return o_lat, o_ctx


def sq_relu_mlp(h, w_in, w_out):
    return jnp.square(jax.nn.relu(h @ w_in)) @ w_out


def setup_inputs(seed: int = 0) -> dict:
    key = jax.random.key(seed)
    ks = jax.random.split(key, 20)
    f32 = jnp.float32
    nrm = lambda k, shape: jax.random.normal(k, shape, f32)
    gain = lambda k, shape: 1.0 + 0.05 * nrm(k, shape)
    return {
        'x': nrm(ks[0], (BATCH, SEQ, D_MODEL)),
        'c': nrm(ks[1], (BATCH, D_MODEL)),
        'ctx': nrm(ks[2], (BATCH, CTX_LEN, D_MODEL)),
        'c_ctx': nrm(ks[3], (D_MODEL,)),
        'w_ada': nrm(ks[4], (DEPTH, D_MODEL, N_MOD * D_MODEL)) * (0.5 * D_MODEL ** -0.5),
        'b_ada': 0.01 * nrm(ks[5], (DEPTH, N_MOD * D_MODEL)),
        'g_mix_pre': gain(ks[6], (DEPTH, D_MODEL)),
        'g_mix_post': gain(ks[7], (DEPTH, D_MODEL)),
        'g_mlp_pre': gain(ks[8], (DEPTH, D_MODEL)),
        'g_mlp_post': gain(ks[9], (DEPTH, D_MODEL)),
        'w_pool': nrm(ks[10], (N_POOL_LAYERS, N_POOL_GROUPS, POOL_GROUP_DIM, POOL_GROUP_DIM)) * POOL_GROUP_DIM ** -0.5,
        'pool_scale': 1.0 + 0.1 * nrm(ks[11], (N_POOL_LAYERS, D_MODEL)),
        'w_qkv': nrm(ks[12], (N_ATTN_LAYERS, D_MODEL, QKV_DIM)) * D_MODEL ** -0.5,
        'g_q': gain(ks[13], (N_ATTN_LAYERS, HEAD_DIM)),
        'g_k': gain(ks[14], (N_ATTN_LAYERS, HEAD_DIM)),
        'w_o': nrm(ks[15], (N_ATTN_LAYERS, D_MODEL, D_MODEL)) * D_MODEL ** -0.5,
        'w_mlp_in': nrm(ks[16], (DEPTH, D_MODEL, D_FF)) * D_MODEL ** -0.5,
        'w_mlp_out': nrm(ks[17], (DEPTH, D_FF, D_MODEL)) * D_FF ** -0.5,
    }


def reference(x, c, ctx, c_ctx, w_ada, b_ada, g_mix_pre, g_mix_post, g_mlp_pre, g_mlp_post,
              w_pool, pool_scale, w_qkv, g_q, g_k, w_o, w_mlp_in, w_mlp_out):
    for i in range(DEPTH):
        last = i == DEPTH - 1
        j = i // N_MIXERS
        sh1, sc1, gt1, sh2, sc2, gt2 = ada_mods(c, w_ada[i], b_ada[i])
        csh1, csc1, cgt1, csh2, csc2, cgt2 = ada_mods(c_ctx, w_ada[i], b_ada[i])
        h_lat = modulate(rms_norm(x, g_mix_pre[i]), sh1, sc1)
        h_ctx = modulate(rms_norm(ctx, g_mix_pre[i]), csh1, csc1)
        if i % N_MIXERS == 0:
            y_lat = pool_mixer(h_lat, w_pool[j], pool_scale[j])
            y_ctx = None if last else pool_mixer(h_ctx, w_pool[j], pool_scale[j])
        else:
            y_lat, y_ctx = attention_mixer(h_lat, h_ctx, w_qkv[j], g_q[j], g_k[j], w_o[j], not last)
        x = x + gt1 * rms_norm(y_lat, g_mix_post[i])
        m_lat = sq_relu_mlp(modulate(rms_norm(x, g_mlp_pre[i]), sh2, sc2), w_mlp_in[i], w_mlp_out[i])
        x = x + gt2 * rms_norm(m_lat, g_mlp_post[i])
        if not last:
            ctx = ctx + cgt1 * rms_norm(y_ctx, g_mix_post[i])
            m_ctx = sq_relu_mlp(modulate(rms_norm(ctx, g_mlp_pre[i]), csh2, csc2), w_mlp_in[i], w_mlp_out[i])
            ctx = ctx + cgt2 * rms_norm(m_ctx, g_mlp_post[i])
    return x
```

```cpp
#include <hip/hip_runtime.h>
#include <hip/hip_bf16.h>
#include <hip/hip_cooperative_groups.h>
#include <cstdio>
#include <cstdint>
namespace cg = cooperative_groups;

namespace pg8 {
#define PG8_LAS __attribute__((address_space(3)))
typedef unsigned short bf16_t;
typedef short bf16x8 __attribute__((ext_vector_type(8)));
typedef float f32x4 __attribute__((ext_vector_type(4)));
typedef unsigned u32x4 __attribute__((ext_vector_type(4)));
constexpr int BM = 256, BK = 64, HALF = 128, HTB = HALF * BK * 2  , STAGE_BYTES = 8 * HTB, NXCD = 8, WGM = 8;

__host__ __device__ __forceinline__ int lds_byte(int r, int c) { const int st = (r >> 4) * 2 + (c >> 5), rr = r & 15, cc = c & 31, ob = rr * 64 + cc * 2; return st * 1024 + (ob ^ (((ob >> 9) & 1) << 5)); }
__host__ __device__ __forceinline__ void stage_rc(int b, int& R, int& C) { const int st = b / 1024, sb = b % 1024, swz = sb ^ (((sb >> 9) & 1) << 5); R = (st >> 1) * 16 + swz / 64; C = (st & 1) * 32 + (swz % 64) / 2; }
__host__ __device__ __forceinline__ int perm32(int rho) { const int n = rho >> 4, i = rho & 15; return 8 * (i >> 2) + 4 * n + (i & 3); }

struct Unit { int pm, pn; };
struct Gemm { const bf16_t* A; const bf16_t* Bt; int M, N, K, lda, ldb, adiv, bmod; size_t a_step, b_step; };

struct StaticOrder {
    int nM, nN, nwg, G, c;
    __host__ __device__ void init(int M, int N, int G_, int c_) { nM = M / BM; nN = N / BM; nwg = nM * nN; G = G_; c = c_; }
    __host__ __device__ bool next(int i, Unit& u) const {
        const long L = (long)i * G + c; if (L >= nwg) return false;
        int wgid = (int)L; { const int q = nwg / NXCD, r = nwg % NXCD, xcd = wgid % NXCD, off = wgid / NXCD; wgid = (xcd < r ? xcd * (q + 1) : r * (q + 1) + (xcd - r) * q) + off; }
        const int nig = WGM * nN, gid = wgid / nig, fm = gid * WGM, gsz = (nM - fm) < WGM ? (nM - fm) : WGM;
        u.pm = fm + ((wgid % nig) % gsz); u.pn = (wgid % nig) / gsz; return true;
    }
    __device__ __forceinline__ void a_ready(const Unit&) const {}
    __device__ __forceinline__ void done(const Unit&) const {}
};

__device__ __forceinline__ unsigned cvt_pk_bf16(float lo, float hi) { unsigned r; asm volatile("v_cvt_pk_bf16_f32 %0, %1, %2" : "=v"(r) : "v"(lo), "v"(hi)); return r; }
template <int ACT> struct EpiStore {
    static constexpr bool PERM = true, PERM2 = false, AFTER_DRAIN = false;
    bf16_t* O; int ldc; const float* cs;
    __device__ __forceinline__ void operator()(const f32x4 (&acc)[2][2][4][2], const Unit& u, int wr, int wc, int fr, int fq) const {
        const int row0 = u.pm * BM + wr * 64 + fr; const int col0 = u.pn * BM + wc * 32 + 8 * fq;
        f32x4 sv[2][2];
#pragma unroll
        for (int bj = 0; bj < 2; ++bj)
#pragma unroll
            for (int n = 0; n < 2; ++n) sv[bj][n] = (ACT == 2) ? *(const f32x4*)(cs + col0 + bj * HALF + 4 * n) : (f32x4){1.f, 1.f, 1.f, 1.f};
#pragma unroll
        for (int ai = 0; ai < 2; ++ai)
#pragma unroll
            for (int m = 0; m < 4; ++m) { bf16_t* rowp = O + (size_t)(row0 + ai * HALF + m * 16) * ldc + col0;
#pragma unroll
                for (int bj = 0; bj < 2; ++bj) { f32x4 v0 = acc[ai][bj][m][0], v1 = acc[ai][bj][m][1];
                    if (ACT == 1) { v0 = __builtin_elementwise_max(v0, (f32x4){0.f, 0.f, 0.f, 0.f}); v1 = __builtin_elementwise_max(v1, (f32x4){0.f, 0.f, 0.f, 0.f}); v0 = v0 * v0; v1 = v1 * v1; }
                    if (ACT == 2) { v0 = v0 * sv[bj][0]; v1 = v1 * sv[bj][1]; }
                    u32x4 w; w.x = cvt_pk_bf16(v0[0], v0[1]); w.y = cvt_pk_bf16(v0[2], v0[3]); w.z = cvt_pk_bf16(v1[0], v1[1]); w.w = cvt_pk_bf16(v1[2], v1[3]);
                    *(u32x4*)(rowp + bj * HALF) = w; } }
    }
};
struct EpiPart {
    static constexpr bool PERM = true, PERM2 = false, AFTER_DRAIN = false;
    float* P;
    __device__ __forceinline__ void operator()(const f32x4 (&acc)[2][2][4][2], const Unit& u, int wr, int wc, int fr, int fq) const {
        const int ks = u.pn >> 2, ct = u.pn & 3;
        const int row0 = u.pm * BM + wr * 64 + fr; const int col0 = ct * BM + wc * 32 + 8 * fq;
        float* base = P + (size_t)ks * 512 * 1024;
#pragma unroll
        for (int ai = 0; ai < 2; ++ai)
#pragma unroll
            for (int m = 0; m < 4; ++m) { float* rowp = base + (size_t)(row0 + ai * HALF + m * 16) * 1024 + col0;
#pragma unroll
                for (int bj = 0; bj < 2; ++bj) { *(f32x4*)(rowp + bj * HALF) = acc[ai][bj][m][0]; *(f32x4*)(rowp + bj * HALF + 4) = acc[ai][bj][m][1]; } }
    }
};
struct EpiQKV {
    static constexpr bool PERM = true, PERM2 = true, AFTER_DRAIN = false;
    bf16_t* Q; bf16_t* Kb; bf16_t* Vb; int skv, seq_tiles;
    const float* gk; const float* rc; const float* rsn; PG8_LAS float* P; float eps;
    __device__ __forceinline__ void operator()(const f32x4 (&acc)[2][2][4][2], const Unit& u, int wr, int wc, int fr, int fq) const {
        bf16_t* base; int ldc, rowbase, colt;
        const int nlat = 2 * seq_tiles;
        if (u.pn < 4) { base = Q; ldc = 1024; rowbase = u.pm * BM; colt = u.pn * BM; }
        else { base = (u.pn == 4) ? Kb : Vb; ldc = 256; colt = 0;
               rowbase = (u.pm < nlat) ? (u.pm / seq_tiles) * skv + 256 + (u.pm % seq_tiles) * 256 : (u.pm - nlat) * skv; }
        const int hb = 64 * (wc & 1);
        const int col0 = colt + 128 * (wc >> 1) + hb + 8 * fq;
        if (u.pn != 4) {
#pragma unroll
            for (int ai = 0; ai < 2; ++ai)
#pragma unroll
                for (int m = 0; m < 4; ++m) { bf16_t* rowp = base + (size_t)(rowbase + wr * 64 + fr + ai * HALF + m * 16) * ldc + col0;
#pragma unroll
                    for (int n = 0; n < 2; ++n) { const f32x4 v0 = acc[ai][0][m][n], v1 = acc[ai][1][m][n];
                        u32x4 w; w.x = cvt_pk_bf16(v0[0], v0[1]); w.y = cvt_pk_bf16(v0[2], v0[3]); w.z = cvt_pk_bf16(v1[0], v1[1]); w.w = cvt_pk_bf16(v1[2], v1[3]);
                        *(u32x4*)(rowp + 32 * n) = w; } }
            return;
        }
#pragma unroll
        for (int ai = 0; ai < 2; ++ai)
#pragma unroll
            for (int m = 0; m < 4; ++m) { float q = 0.f;
#pragma unroll
                for (int bj = 0; bj < 2; ++bj)
#pragma unroll
                    for (int n = 0; n < 2; ++n) { const f32x4 x = acc[ai][bj][m][n]; q += (x[0] * x[0] + x[1] * x[1]) + (x[2] * x[2] + x[3] * x[3]); }
                q += __shfl_xor(q, 16); q += __shfl_xor(q, 32);
                if (fq == 0) P[(ai * HALF + wr * 64 + m * 16 + fr) * 4 + wc] = q; }
        asm volatile("s_waitcnt lgkmcnt(0)" ::: "memory"); __builtin_amdgcn_s_barrier(); asm volatile("" ::: "memory");
        const bool lat = u.pm < nlat; const int tbase = lat ? (u.pm % seq_tiles) * 256 : 0;
        f32x4 g0[2], g1[2];
#pragma unroll
        for (int bj = 0; bj < 2; ++bj) { g0[bj] = *(const f32x4*)(gk + hb + 8 * fq + 4 * bj); g1[bj] = *(const f32x4*)(gk + hb + 32 + 8 * fq + 4 * bj); }
        typedef float f32x2_t __attribute__((ext_vector_type(2)));
#pragma unroll
        for (int ai = 0; ai < 2; ++ai)
#pragma unroll
            for (int m = 0; m < 4; ++m) { const int r = ai * HALF + wr * 64 + m * 16 + fr;
                const f32x2_t pp = *(const PG8_LAS f32x2_t*)(P + r * 4 + 2 * (wc >> 1));
                const float rn = 1.0f / sqrtf((pp[0] + pp[1]) * (1.0f / 128.0f) + eps);
                int p = 0; if (lat) { const int t = tbase + r; p = ((wc & 1) == 0) ? (t >> 6) : (t & 63); }
                u32x4 w1, w2;
#pragma unroll
                for (int bj = 0; bj < 2; ++bj) {
                    f32x4 cs = {1.f, 1.f, 1.f, 1.f}, sn = {0.f, 0.f, 0.f, 0.f};
                    if (lat) { cs = *(const f32x4*)(rc + p * 32 + 8 * fq + 4 * bj); sn = *(const f32x4*)(rsn + p * 32 + 8 * fq + 4 * bj); }
                    const f32x4 x1 = (acc[ai][bj][m][0] * rn) * g0[bj], x2 = (acc[ai][bj][m][1] * rn) * g1[bj];
                    const f32x4 o1 = x1 * cs - x2 * sn, o2 = x2 * cs + x1 * sn;
                    if (bj == 0) { w1.x = cvt_pk_bf16(o1[0], o1[1]); w1.y = cvt_pk_bf16(o1[2], o1[3]); w2.x = cvt_pk_bf16(o2[0], o2[1]); w2.y = cvt_pk_bf16(o2[2], o2[3]); }
                    else         { w1.z = cvt_pk_bf16(o1[0], o1[1]); w1.w = cvt_pk_bf16(o1[2], o1[3]); w2.z = cvt_pk_bf16(o2[0], o2[1]); w2.w = cvt_pk_bf16(o2[2], o2[3]); } }
                bf16_t* rowp = base + (size_t)(rowbase + r) * ldc + col0;
                *(u32x4*)(rowp) = w1; *(u32x4*)(rowp + 32) = w2; }
    }
};
template <class Epi, class Sched, bool ALIGN_EPI = false, bool SP2 = false>
__device__ __forceinline__ void gemm_phase(PG8_LAS unsigned char* lds, const Gemm g, const Sched& S, const Epi& E) {
    const int tid = threadIdx.x, wid = __builtin_amdgcn_readfirstlane(tid >> 6), lane = tid & 63, wr = wid >> 2, wc = wid & 3, fr = lane & 15, fq = lane >> 4;
    const int K = g.K, nt = K / BK;
    unsigned voffA[2], voffB[2];
#pragma unroll
    for (int i = 0; i < 2; ++i) { int R, C; stage_rc(tid * 16 + i * 8192, R, C); const int Rb = Epi::PERM2 ? (128 * ((R >> 6) & 1) + 64 * ((R >> 5) & 1) + 32 * ((R >> 4) & 1) + 8 * ((R & 15) >> 2) + (R & 3)) : (Epi::PERM ? ((R & ~31) + perm32(R & 31)) : R);
        voffA[i] = (unsigned)(R * g.lda + C) * 2u; voffB[i] = (unsigned)(Rb * g.ldb + C) * 2u; }
    const size_t kstep = (size_t)(BK * 2);
    const size_t hstepA = (size_t)HALF * g.lda * 2, hstepB = Epi::PERM2 ? (size_t)4 * g.ldb * 2 : (size_t)HALF * g.ldb * 2;
    const size_t tstepA = 2 * hstepA, tstepB = (size_t)2 * HALF * g.ldb * 2;
    const unsigned ldsw = (unsigned)wid * 1024u;
    const int aoff = lds_byte(wr * 64 + fr, fq * 8), boff = lds_byte(wc * 32 + fr, fq * 8);
#define PG8_SA(b, h) (((b) * 2 + (h)) * HTB)
#define PG8_SB(b, h) ((4 + (b) * 2 + (h)) * HTB)
#define PG8_STAGE(bufoff, gbase, voff) do { _Pragma("unroll") for (int _i = 0; _i < 2; ++_i) \
        __builtin_amdgcn_global_load_lds((const unsigned*)((const char*)(gbase) + (voff)[_i]), (PG8_LAS unsigned*)(lds + (bufoff) + ldsw + _i * 8192), 16, 0, 0); } while (0)
#define PG8_LDA(dst, b, h) do { _Pragma("unroll") for (int m = 0; m < 4; ++m) _Pragma("unroll") for (int k = 0; k < 2; ++k) dst[m][k] = *(const PG8_LAS bf16x8*)(lds + PG8_SA(b, h) + aoff + m * 2048 + k * 1024); } while (0)
#define PG8_LDB(dst, b, h) do { _Pragma("unroll") for (int n = 0; n < 2; ++n) _Pragma("unroll") for (int k = 0; k < 2; ++k) dst[n][k] = *(const PG8_LAS bf16x8*)(lds + PG8_SB(b, h) + boff + n * 2048 + k * 1024); } while (0)
#define PG8_MMA(ai, bj, At, Bt) do { __builtin_amdgcn_s_setprio(1); _Pragma("unroll") for (int m = 0; m < 4; ++m) _Pragma("unroll") for (int n = 0; n < 2; ++n) _Pragma("unroll") for (int k = 0; k < 2; ++k) \
        acc[ai][bj][m][n] = __builtin_amdgcn_mfma_f32_16x16x32_bf16(Bt[n][k], At[m][k], acc[ai][bj][m][n], 0, 0, 0); __builtin_amdgcn_s_setprio(0); } while (0)
#define PG8_WAIT_V(n) asm volatile("s_waitcnt vmcnt(" #n ")" ::: "memory")
#define PG8_WAIT_L(n) asm volatile("s_waitcnt lgkmcnt(" #n ")" ::: "memory")
#define PG8_BAR __builtin_amdgcn_s_barrier()
#define PG8_SCHED __builtin_amdgcn_sched_barrier(0)
    Unit cur, nxt; int ui = 0;
    if (!S.next(0, cur)) return;
    f32x4 acc[2][2][4][2];
#pragma unroll
    for (int a = 0; a < 2; ++a)
#pragma unroll
        for (int b = 0; b < 2; ++b)
#pragma unroll
            for (int m = 0; m < 4; ++m)
#pragma unroll
                for (int n = 0; n < 2; ++n) acc[a][b][m][n] = (f32x4){0.f, 0.f, 0.f, 0.f};
    bf16x8 At[4][2], B0[2][2], B1[2][2];
    const char* cA = (const char*)g.A + (size_t)cur.pm * tstepA + (size_t)(cur.pn / g.adiv) * g.a_step; const char* cB = (const char*)g.Bt + (size_t)(cur.pn % g.bmod) * tstepB + (size_t)(cur.pn / g.adiv) * g.b_step;
    S.a_ready(cur);
    if constexpr (SP2) {
        PG8_STAGE(PG8_SB(0, 0), cB, voffB); PG8_STAGE(PG8_SB(0, 1), cB + hstepB, voffB); PG8_STAGE(PG8_SA(0, 0), cA, voffA); PG8_STAGE(PG8_SA(0, 1), cA + hstepA, voffA);
        if (wr == 1) PG8_BAR;
        PG8_WAIT_V(2); PG8_BAR;
        PG8_STAGE(PG8_SB(1, 0), cB + kstep, voffB); PG8_STAGE(PG8_SA(1, 0), cA + kstep, voffA); PG8_STAGE(PG8_SB(1, 1), cB + hstepB + kstep, voffB);
        PG8_WAIT_V(6); PG8_BAR;
    } else {
        PG8_STAGE(PG8_SB(0, 0), cB, voffB); PG8_STAGE(PG8_SA(0, 0), cA, voffA); PG8_STAGE(PG8_SB(0, 1), cB + hstepB, voffB); PG8_STAGE(PG8_SA(0, 1), cA + hstepA, voffA);
        if (wr == 1) PG8_BAR;
        PG8_WAIT_V(4); PG8_BAR;
        PG8_STAGE(PG8_SB(1, 0), cB + kstep, voffB); PG8_STAGE(PG8_SA(1, 0), cA + kstep, voffA); PG8_STAGE(PG8_SB(1, 1), cB + hstepB + kstep, voffB);
        PG8_WAIT_V(6); PG8_BAR;
    }
    for (;;) {
        const bool has_next = S.next(ui + 1, nxt);
        const char* nA = has_next ? (const char*)g.A + (size_t)nxt.pm * tstepA + (size_t)(nxt.pn / g.adiv) * g.a_step : cA; const char* nB = has_next ? (const char*)g.Bt + (size_t)(nxt.pn % g.bmod) * tstepB + (size_t)(nxt.pn / g.adiv) * g.b_step : cB;
        for (int t = 0; t < nt; t += 2) {
            const bool last = (t == nt - 2);
            const char* a1 = cA + (size_t)(t + 1) * kstep;
            const char* a2 = last ? nA : cA + (size_t)(t + 2) * kstep; const char* b2 = last ? nB : cB + (size_t)(t + 2) * kstep;
            const char* a3 = a2 + kstep; const char* b3 = b2 + kstep;
            if (last && has_next) S.a_ready(nxt);
            if constexpr (SP2) {
            PG8_LDB(B0, 0, 0); PG8_LDB(B1, 0, 1); PG8_SCHED; PG8_LDA(At, 0, 0); PG8_STAGE(PG8_SA(1, 1), a1 + hstepA, voffA);
            PG8_WAIT_V(8); PG8_WAIT_L(0); PG8_BAR; PG8_MMA(0, 0, At, B0); PG8_MMA(0, 1, At, B1); PG8_BAR; PG8_SCHED;
            PG8_LDA(At, 0, 1); PG8_STAGE(PG8_SB(0, 0), b2, voffB); PG8_STAGE(PG8_SB(0, 1), b2 + hstepB, voffB); PG8_STAGE(PG8_SA(0, 0), a2, voffA);
            PG8_WAIT_V(8); PG8_WAIT_L(0); PG8_BAR; PG8_MMA(1, 0, At, B0); PG8_MMA(1, 1, At, B1); PG8_BAR; PG8_SCHED;
            PG8_LDB(B0, 1, 0); PG8_LDB(B1, 1, 1); PG8_SCHED; PG8_LDA(At, 1, 0); PG8_STAGE(PG8_SA(0, 1), a2 + hstepA, voffA);
            PG8_WAIT_V(8); PG8_WAIT_L(0); PG8_BAR; PG8_MMA(0, 0, At, B0); PG8_MMA(0, 1, At, B1); PG8_BAR; PG8_SCHED;
            PG8_LDA(At, 1, 1); PG8_STAGE(PG8_SB(1, 0), b3, voffB); PG8_STAGE(PG8_SB(1, 1), b3 + hstepB, voffB); PG8_STAGE(PG8_SA(1, 0), a3, voffA);
            PG8_WAIT_V(8); PG8_WAIT_L(0); PG8_BAR; PG8_MMA(1, 0, At, B0); PG8_MMA(1, 1, At, B1); PG8_BAR; PG8_SCHED;
            } else {
            PG8_LDB(B0, 0, 0); PG8_SCHED; PG8_LDA(At, 0, 0); PG8_STAGE(PG8_SA(1, 1), a1 + hstepA, voffA);
            PG8_WAIT_L(8); PG8_BAR; PG8_WAIT_L(0); PG8_MMA(0, 0, At, B0); PG8_BAR; PG8_SCHED;
            PG8_LDB(B1, 0, 1); PG8_STAGE(PG8_SB(0, 0), b2, voffB);
            PG8_BAR; PG8_WAIT_L(0); PG8_MMA(0, 1, At, B1); PG8_BAR;
            PG8_LDA(At, 0, 1); PG8_STAGE(PG8_SA(0, 0), a2, voffA);
            PG8_BAR; PG8_WAIT_L(0); PG8_MMA(1, 0, At, B0); PG8_BAR; PG8_SCHED;
            PG8_STAGE(PG8_SB(0, 1), b2 + hstepB, voffB);
            PG8_WAIT_V(6); PG8_BAR; PG8_MMA(1, 1, At, B1); PG8_BAR;
            PG8_LDB(B0, 1, 0); PG8_SCHED; PG8_LDA(At, 1, 0); PG8_STAGE(PG8_SA(0, 1), a2 + hstepA, voffA);
            PG8_WAIT_L(8); PG8_BAR; PG8_WAIT_L(0); PG8_MMA(0, 0, At, B0); PG8_BAR; PG8_SCHED;
            PG8_LDB(B1, 1, 1); PG8_STAGE(PG8_SB(1, 0), b3, voffB);
            PG8_BAR; PG8_WAIT_L(0); PG8_MMA(0, 1, At, B1); PG8_BAR;
            PG8_LDA(At, 1, 1); PG8_STAGE(PG8_SA(1, 0), a3, voffA);
            PG8_BAR; PG8_WAIT_L(0); PG8_MMA(1, 0, At, B0); PG8_BAR; PG8_SCHED;
            PG8_STAGE(PG8_SB(1, 1), b3 + hstepB, voffB);
            PG8_WAIT_V(6); PG8_BAR; PG8_MMA(1, 1, At, B1); PG8_BAR;
            }
        }
        if constexpr (ALIGN_EPI) { if (wr == 0) PG8_BAR; }
        if constexpr (!Epi::AFTER_DRAIN) { E(acc, cur, wr, wc, fr, fq); S.done(cur); }
        if (!has_next) break;
#pragma unroll
        for (int a = 0; a < 2; ++a)
#pragma unroll
            for (int b = 0; b < 2; ++b)
#pragma unroll
                for (int m = 0; m < 4; ++m)
#pragma unroll
                    for (int n = 0; n < 2; ++n) acc[a][b][m][n] = (f32x4){0.f, 0.f, 0.f, 0.f};
        cur = nxt; cA = nA; cB = nB; ++ui;
        if constexpr (ALIGN_EPI) { if (wr == 1) PG8_BAR; }
    }
    PG8_WAIT_V(0);
    if constexpr (!ALIGN_EPI) { if (wr == 0) PG8_BAR; }
    PG8_BAR;
    if constexpr (Epi::AFTER_DRAIN) { E.fused(acc, cur, wr, wc, fr, fq, lds, wid, lane); S.done(cur); }
#undef PG8_SA
#undef PG8_SB
#undef PG8_STAGE
#undef PG8_LDA
#undef PG8_LDB
#undef PG8_MMA
#undef PG8_WAIT_V
#undef PG8_WAIT_L
#undef PG8_BAR
#undef PG8_SCHED
}
}
namespace att {
using bf16 = __hip_bfloat16;
constexpr int   D = 128, NW = 8, QBLK = 32, KVBLK = 64;
constexpr float SCALE = 0.088388347648318440f;
constexpr float THR = 8.f;
constexpr int SDEPTH = 1;
constexpr int LDQ = 1024, LDK = 256, LDO = 1024;
constexpr size_t SHM_V = KVBLK * D * 2, SHM_K = KVBLK * D * 2, SHM_ATTN = 2 * SHM_V + 2 * SHM_K + NW * 64 * 4;
using bf16x8 = __attribute__((ext_vector_type(8))) short;
using s16x4  = __attribute__((ext_vector_type(4))) short;
using f32x16 = __attribute__((ext_vector_type(16))) float;
using f32x8  = __attribute__((ext_vector_type(8))) float;
using u32x4  = __attribute__((ext_vector_type(4))) unsigned;
#define KSWZ(row, colB) ((row) * 256 + ((colB) ^ (((row) & 7) << 4)))
#define SBAR() __builtin_amdgcn_sched_barrier(0)
__device__ __forceinline__ int crow(int r, int hi) { return (r & 3) + 8 * (r >> 2) + 4 * hi; }
__device__ __forceinline__ unsigned cvtpk(float lo, float hi) {
  unsigned r; asm volatile("v_cvt_pk_bf16_f32 %0, %1, %2" : "=v"(r) : "v"(lo), "v"(hi)); return r;
}
template <typename TIn> struct Stage;
template <> struct Stage<bf16>  { using T = bf16x8;
  __device__ static __forceinline__ T ld8(const bf16* p) { return *reinterpret_cast<const bf16x8*>(p); }
  __device__ static __forceinline__ bf16x8 tobf(T x) { return x; } };
template <> struct Stage<float> { using T = f32x8;
  __device__ static __forceinline__ T ld8(const float* p) { return *reinterpret_cast<const f32x8*>(p); }
  __device__ static __forceinline__ bf16x8 tobf(T x) {
    u32x4 w = {cvtpk(x[0], x[1]), cvtpk(x[2], x[3]), cvtpk(x[4], x[5]), cvtpk(x[6], x[7])}; return *reinterpret_cast<bf16x8*>(&w); } };

__device__ __forceinline__ void partialSM(f32x16& p0, f32x16& p1, float mC) {
  (void)mC; (void)p1;
  for (int r = 0; r < 16; ++r) p0[r] = __builtin_amdgcn_exp2f(p0[r]);
}
__device__ __forceinline__ void finishSM(f32x16& p0, f32x16& p1, float& l_reg, bf16x8& pa0, bf16x8& pa1, bf16x8& pa2, bf16x8& pa3) {
  for (int r = 0; r < 16; ++r) p1[r] = __builtin_amdgcn_exp2f(p1[r]);
  float ps = 0; for (int r = 0; r < 16; ++r) ps += p0[r]; for (int r = 0; r < 16; ++r) ps += p1[r];
  { auto rr = __builtin_amdgcn_permlane32_swap(__float_as_uint(ps), __float_as_uint(ps), false, false);
    ps = __uint_as_float(rr[0]) + __uint_as_float(rr[1]); }
  l_reg += ps;
#define PK4(P, BASE, OUT) do { unsigned a0 = cvtpk(P[BASE + 0], P[BASE + 1]), a1 = cvtpk(P[BASE + 2], P[BASE + 3]);   \
    unsigned b0 = cvtpk(P[BASE + 4], P[BASE + 5]), b1 = cvtpk(P[BASE + 6], P[BASE + 7]);                              \
    auto r0 = __builtin_amdgcn_permlane32_swap(a0, b0, false, false); auto r1 = __builtin_amdgcn_permlane32_swap(a1, b1, false, false); \
    u32x4 w = {r0[0], r1[0], r0[1], r1[1]}; OUT = *reinterpret_cast<bf16x8*>(&w); } while (0)
  PK4(p0, 0, pa0); PK4(p0, 8, pa1); PK4(p1, 0, pa2); PK4(p1, 8, pa3);
#undef PK4
}
__device__ __forceinline__ void qkt(f32x16& p0, f32x16& p1, const bf16* Ks, const bf16x8* qr, int r32, int hi, const f32x16& negm) {
#pragma unroll
  for (int d0 = 0; d0 < 8; ++d0) { int cb = (d0 * 16 + hi * 8) * 2;
    bf16x8 b0 = *reinterpret_cast<const bf16x8*>((const char*)Ks + KSWZ(r32, cb));
    bf16x8 b1 = *reinterpret_cast<const bf16x8*>((const char*)Ks + KSWZ(32 + r32, cb));
    if (d0 == 0) { p0 = __builtin_amdgcn_mfma_f32_32x32x16_bf16(b0, qr[0], negm, 0, 0, 0); p1 = __builtin_amdgcn_mfma_f32_32x32x16_bf16(b1, qr[0], negm, 0, 0, 0); }
    else { p0 = __builtin_amdgcn_mfma_f32_32x32x16_bf16(b0, qr[d0], p0, 0, 0, 0); p1 = __builtin_amdgcn_mfma_f32_32x32x16_bf16(b1, qr[d0], p1, 0, 0, 0); } }
}
__device__ __forceinline__ int v_st(int k, int c) { const int kk = (k & ~0xC) | ((k & 4) << 1) | ((k & 8) >> 1); return ((kk >> 3) * 4 + (c >> 5)) * 512 + ((kk & 7) * 32 + (c & 31)) * 2; }
__device__ __forceinline__ int v_rd_base(int lane) { return ((lane & 3) << 3) | (((lane >> 2) & 3) << 6) | (((lane >> 4) & 1) << 5) | (((lane >> 5) & 1) << 8); }
constexpr int v_rd_off(int d0, int ks, int half) { return d0 * 512 + ks * 4096 + half * 2048; }
template <int OFF> __device__ __forceinline__ s16x4 tr_read(int vb) {
  s16x4 r; asm volatile("ds_read_b64_tr_b16 %0, %1 offset:%2" : "=&v"(r) : "v"(vb), "i"(OFF) : "memory"); return r;
}
template <int D0> __device__ __forceinline__ void pv_one(f32x16& od, int vb, bf16x8 pa0, bf16x8 pa1, bf16x8 pa2, bf16x8 pa3) {
  const s16x4 l0 = tr_read<v_rd_off(D0, 0, 0)>(vb), h0 = tr_read<v_rd_off(D0, 0, 1)>(vb), l1 = tr_read<v_rd_off(D0, 1, 0)>(vb), h1 = tr_read<v_rd_off(D0, 1, 1)>(vb);
  const s16x4 l2 = tr_read<v_rd_off(D0, 2, 0)>(vb), h2 = tr_read<v_rd_off(D0, 2, 1)>(vb), l3 = tr_read<v_rd_off(D0, 3, 0)>(vb), h3 = tr_read<v_rd_off(D0, 3, 1)>(vb);
  asm volatile("s_waitcnt lgkmcnt(0)" ::: "memory"); SBAR();
#define PK(L, H) (bf16x8){L[0], L[1], L[2], L[3], H[0], H[1], H[2], H[3]}
  od = __builtin_amdgcn_mfma_f32_32x32x16_bf16(pa0, PK(l0, h0), od, 0, 0, 0);
  od = __builtin_amdgcn_mfma_f32_32x32x16_bf16(pa1, PK(l1, h1), od, 0, 0, 0);
  od = __builtin_amdgcn_mfma_f32_32x32x16_bf16(pa2, PK(l2, h2), od, 0, 0, 0);
  od = __builtin_amdgcn_mfma_f32_32x32x16_bf16(pa3, PK(l3, h3), od, 0, 0, 0);
#undef PK
}
__device__ __forceinline__ void pv_d0(f32x16* o, int vb, bf16x8 pa0, bf16x8 pa1, bf16x8 pa2, bf16x8 pa3) {
  pv_one<0>(o[0], vb, pa0, pa1, pa2, pa3); pv_one<1>(o[1], vb, pa0, pa1, pa2, pa3); pv_one<2>(o[2], vb, pa0, pa1, pa2, pa3); pv_one<3>(o[3], vb, pa0, pa1, pa2, pa3);
}

template <typename TQ>
__device__ __forceinline__ void attn_dense_body(const TQ* __restrict__ Qb, const bf16* __restrict__ Kh, const bf16* __restrict__ Vh,
                                                bf16* __restrict__ Ob, int seq, char* lds, float mC, const float* __restrict__ gq, const float* __restrict__ rc, const float* __restrict__ rsn, int trow0) {
  using St = Stage<bf16>; using SQ = Stage<TQ>;
  int tid_ = threadIdx.x; asm volatile("" : "+v"(tid_));
  const int tid = tid_, wid = __builtin_amdgcn_readfirstlane(tid >> 6), lane = tid & 63, r32 = lane & 31, hi = lane >> 5;
  bf16* V_lds = (bf16*)lds; bf16* K_lds = (bf16*)(lds + 2 * SHM_V);
  float* ws = (float*)(lds + 2 * SHM_V + 2 * SHM_K) + wid * 64; float* li_l = ws;
  float l_reg = 0; f32x16 o[4] = {}; bf16x8 qr[8];
  const TQ* Qw = Qb + (long)(wid * QBLK + r32) * LDQ + hi * 8;
#pragma unroll
  for (int d0 = 0; d0 < 8; ++d0) qr[d0] = SQ::tobf(SQ::ld8(Qw + d0 * 16));
  const int sr = tid >> 4, sc = (tid & 15) * 8, vst0 = v_st(sr, sc), vst1 = v_st(32 + sr, sc);
  const int vb0 = (int)(uintptr_t)V_lds + v_rd_base(lane);
  struct { typename St::T vs0, vs1, ks0, ks1; } sr_[SDEPTH];
#define SLOAD(i, k0) do { sr_[i].vs0 = St::ld8(&Vh[(long)((k0) + sr) * LDK + sc]); sr_[i].vs1 = St::ld8(&Vh[(long)((k0) + 32 + sr) * LDK + sc]); \
    sr_[i].ks0 = St::ld8(&Kh[(long)((k0) + sr) * LDK + sc]); sr_[i].ks1 = St::ld8(&Kh[(long)((k0) + 32 + sr) * LDK + sc]); } while (0)
#define SWRITE(b, i) do { *(bf16x8*)((char*)V_lds + (b) * SHM_V + vst0) = St::tobf(sr_[i].vs0);          \
    *(bf16x8*)((char*)V_lds + (b) * SHM_V + vst1) = St::tobf(sr_[i].vs1); int kc = sc * 2;               \
    *(bf16x8*)((char*)K_lds + (b) * SHM_K + KSWZ(sr, kc)) = St::tobf(sr_[i].ks0);                       \
    *(bf16x8*)((char*)K_lds + (b) * SHM_K + KSWZ(32 + sr, kc)) = St::tobf(sr_[i].ks1); } while (0)
#define SWAIT() do { if constexpr (SDEPTH == 2) asm volatile("s_waitcnt vmcnt(4)" ::: "memory"); else asm volatile("s_waitcnt vmcnt(0)" ::: "memory"); } while (0)
  constexpr int SE = 0, SO = SDEPTH - 1;
  SLOAD(SE, 0);
  {
    float ss = 0.f;
#define QF(d, e) __uint_as_float(((unsigned)(unsigned short)qr[d][e]) << 16)
#pragma unroll
    for (int d0 = 0; d0 < 8; ++d0)
#pragma unroll
      for (int e = 0; e < 8; ++e) { const float x = QF(d0, e); ss += x * x; }
    ss += __shfl_xor(ss, 32);
    const float rn = (SCALE * 1.4426950408889634f) / sqrtf(ss * (1.0f / 128.0f) + 1e-6f);
    const int t = trow0 + wid * QBLK + r32; const int prow = t >> 6, pcol = t & 63;
#pragma unroll
    for (int hf = 0; hf < 2; ++hf)
#pragma unroll
      for (int dd = 0; dd < 2; ++dd) {
        const int dl = 4 * hf + dd, du = dl + 2;
        const int f0 = 16 * dd + 8 * hi;
        const float* cp = rc + (hf ? pcol : prow) * 32 + f0; const float* sp = rsn + (hf ? pcol : prow) * 32 + f0;
        const float* gl = gq + 16 * dl + 8 * hi; const float* gu = gq + 16 * du + 8 * hi;
        unsigned wl[4], wu[4];
#pragma unroll
        for (int e = 0; e < 8; e += 2) {
          float o1[2], o2[2];
#pragma unroll
          for (int k = 0; k < 2; ++k) { const float x1 = QF(dl, e + k) * rn * gl[e + k], x2 = QF(du, e + k) * rn * gu[e + k]; const float c = cp[e + k], sn = sp[e + k];
            o1[k] = x1 * c - x2 * sn; o2[k] = x2 * c + x1 * sn; }
          wl[e >> 1] = cvtpk(o1[0], o1[1]); wu[e >> 1] = cvtpk(o2[0], o2[1]);
        }
        u32x4 vl = {wl[0], wl[1], wl[2], wl[3]}, vu = {wu[0], wu[1], wu[2], wu[3]};
        qr[dl] = *reinterpret_cast<bf16x8*>(&vl); qr[du] = *reinterpret_cast<bf16x8*>(&vu);
      }
  }
#undef QF
  SBAR();
  f32x16 pA0, pA1, pB0, pB1; bf16x8 pa0, pa1, pa2, pa3; const int NT = seq / KVBLK;
  f32x16 negm;
#pragma unroll
  for (int r = 0; r < 16; ++r) negm[r] = -mC;
  asm volatile("" : "+v"(negm));
  asm volatile("s_waitcnt vmcnt(0)" ::: "memory"); SWRITE(0, SE); __syncthreads();
  qkt(pA0, pA1, K_lds, qr, r32, hi, negm); partialSM(pA0, pA1, mC);
  SLOAD(SO, KVBLK); if constexpr (SDEPTH == 2) { if (2 < NT) SLOAD(SE, 2 * KVBLK); }
  SWAIT(); SWRITE(1, SO); __syncthreads();
  for (int j = 1; j + 1 < NT; j += 2) {
    SBAR(); qkt(pB0, pB1, (bf16*)((char*)K_lds + SHM_K), qr, r32, hi, negm);
    finishSM(pA0, pA1, l_reg, pa0, pa1, pa2, pa3); SBAR();
    SLOAD(SO, (j + SDEPTH) * KVBLK); SBAR();
    pv_d0(o, vb0, pa0, pa1, pa2, pa3); partialSM(pB0, pB1, mC);
    __syncthreads(); SWAIT(); SWRITE(0, SE);
    __syncthreads();
    SBAR(); qkt(pA0, pA1, K_lds, qr, r32, hi, negm);
    finishSM(pB0, pB1, l_reg, pa0, pa1, pa2, pa3); SBAR();
    if (SDEPTH == 1 || j + 3 < NT) SLOAD(SE, (j + 1 + SDEPTH) * KVBLK); SBAR();
    pv_d0(o, vb0 + (int)SHM_V, pa0, pa1, pa2, pa3); partialSM(pA0, pA1, mC);
    __syncthreads(); SWAIT(); SWRITE(1, SO);
    __syncthreads();
  }
  SBAR(); qkt(pB0, pB1, (bf16*)((char*)K_lds + SHM_K), qr, r32, hi, negm);
  finishSM(pA0, pA1, l_reg, pa0, pa1, pa2, pa3); SBAR();
  pv_d0(o, vb0, pa0, pa1, pa2, pa3); partialSM(pB0, pB1, mC);
  __syncthreads();
  finishSM(pB0, pB1, l_reg, pa0, pa1, pa2, pa3); SBAR();
  pv_d0(o, vb0 + (int)SHM_V, pa0, pa1, pa2, pa3);
  if (hi == 0) li_l[r32] = l_reg; asm volatile("s_waitcnt lgkmcnt(0)" ::: "memory");
  float rli[16];
#pragma unroll
  for (int r = 0; r < 16; ++r) rli[r] = __builtin_amdgcn_rcpf(li_l[crow(r, hi)]);
  int le = (int)(threadIdx.x & 63u); asm volatile("" : "+v"(le));
  const int r32e = le & 31, hie = le >> 5;
  bf16* Ow = Ob + (long)(wid * QBLK) * LDO;
#pragma unroll
  for (int r = 0; r < 16; ++r) { int orow = crow(r, hie);
    for (int d0 = 0; d0 < 4; ++d0) Ow[(long)orow * LDO + d0 * 32 + r32e] = __float2bfloat16(o[d0][r] * rli[r]); }
#undef SLOAD
#undef SWRITE
#undef SWAIT
}
}
constexpr int DM = 1024, NBATCH = 2, SEQ = 8192, CTXL = 256, MLAT = NBATCH * SEQ, MCTX = NBATCH * CTXL, MALL = MLAT + MCTX;
constexpr int FF = 4096, NQKV = 1536, SKV = SEQ + CTXL, MODW = 6 * DM;
constexpr float EPS = 1e-6f;
constexpr int NWAVES = 8, NTHR = 512;
constexpr size_t MiB = 1u << 20;
constexpr size_t WS_CTL = 0;
constexpr size_t WS_MODS = 64 * 1024;
constexpr size_t WS_RSTD = 1 * MiB + 256 * 1024;
constexpr size_t WS_ROPE = 1 * MiB + 512 * 1024;
constexpr size_t WS_XCTX = 2 * MiB;
constexpr size_t WS_WPOOL = 4 * MiB, WS_WQKV = 5 * MiB, WS_WO = 8 * MiB, WS_WIN0 = 10 * MiB, WS_WIN1 = 18 * MiB, WS_WOUT0 = 26 * MiB, WS_WOUT1 = 34 * MiB;
constexpr size_t WS_AY = 42 * MiB;
constexpr size_t WS_H = 76 * MiB;
constexpr size_t WS_DIFF = WS_H, WS_Q = WS_H, WS_K = 110 * MiB, WS_V = 119 * MiB, WS_O = 128 * MiB;
constexpr size_t WS_XB = 208 * MiB;
constexpr int KSPLIT = 8;
constexpr size_t WS_END = 242 * MiB;
static_assert(WS_AY + (size_t)MALL * DM * 2 <= WS_H && WS_H + (size_t)MALL * FF * 2 <= WS_XB && WS_XB + (size_t)MALL * DM * 2 <= WS_END && (size_t)KSPLIT * MCTX * DM <= (size_t)MLAT * DM, "ws map");
static_assert(WS_Q + (size_t)MALL * DM * 2 <= WS_K && WS_K + (size_t)NBATCH * SKV * 256 * 2 <= WS_V && WS_V + (size_t)NBATCH * SKV * 256 * 2 <= WS_O, "ws map 2");

constexpr int RING_BYTES = 131072, LDS_BYTES = 147456;

#define LAS __attribute__((address_space(3)))
typedef unsigned short bf16r;
typedef float f32x4 __attribute__((ext_vector_type(4)));
typedef unsigned u32x2 __attribute__((ext_vector_type(2)));
typedef unsigned u32x4 __attribute__((ext_vector_type(4)));

__device__ __forceinline__ unsigned f2bf(float f) { unsigned u = __builtin_bit_cast(unsigned, f); return (u + 0x7fffu + ((u >> 16) & 1u)) >> 16; }
__device__ __forceinline__ unsigned pk2(float lo, float hi) {
    typedef float f32x2_c __attribute__((ext_vector_type(2))); typedef __bf16 bf16x2_c __attribute__((ext_vector_type(2)));
    const f32x2_c v = {lo, hi}; return __builtin_bit_cast(unsigned, __builtin_convertvector(v, bf16x2_c)); }
__device__ __forceinline__ float bflo(unsigned w) { return __uint_as_float(w << 16); }
__device__ __forceinline__ float bfhi(unsigned w) { return __uint_as_float(w & 0xffff0000u); }
__device__ __forceinline__ float wave_sum(float v) {
#pragma unroll
    for (int o = 1; o < 64; o <<= 1) v += __shfl_xor(v, o);
    return v;
}

struct KArgs {
    const float *x, *c, *ctx, *c_ctx, *w_ada, *b_ada, *g_mix_pre, *g_mix_post, *g_mlp_pre, *g_mlp_post, *w_pool, *pool_scale, *w_qkv, *g_q, *g_k, *w_o, *w_mlp_in, *w_mlp_out;
    float* out; unsigned char* ws; int ph_lo, ph_hi;
};

__device__ __forceinline__ void p0_transpose_item(const float* W, int K, int N, bf16r* WT, int row_off, LAS float* scr, int item, int lane, const float* colscale = nullptr) {
    const int nblk = N / 32, kb = item / nblk, nb = item % nblk, k0 = 64 * kb, n0 = 32 * nb;
    const int kr = lane >> 3, nq = lane & 7;
    f32x4 v[8];
#pragma unroll
    for (int i = 0; i < 8; ++i) v[i] = __builtin_nontemporal_load((const f32x4*)(W + (size_t)(k0 + 8 * i + kr) * N + n0 + 4 * nq));
#pragma unroll
    for (int i = 0; i < 8; ++i) { LAS float* d = scr + (8 * i + kr) * 33 + 4 * nq; d[0] = v[i].x; d[1] = v[i].y; d[2] = v[i].z; d[3] = v[i].w; }
    asm volatile("s_waitcnt lgkmcnt(0)" ::: "memory");
    const int c = lane & 7;
#pragma unroll
    for (int j = 0; j < 4; ++j) { const int n = (lane >> 3) + 8 * j; const LAS float* sp = scr + (8 * c) * 33 + n;
        const float sc = colscale ? colscale[row_off + n0 + n] : 1.0f;
        u32x4 o; o.x = pk2(sp[0 * 33] * sc, sp[1 * 33] * sc); o.y = pk2(sp[2 * 33] * sc, sp[3 * 33] * sc); o.z = pk2(sp[4 * 33] * sc, sp[5 * 33] * sc); o.w = pk2(sp[6 * 33] * sc, sp[7 * 33] * sc);
        *(u32x4*)(WT + (size_t)(row_off + n0 + n) * K + k0 + 8 * c) = o; }
    asm volatile("s_waitcnt lgkmcnt(0)" ::: "memory");
}

__device__ __forceinline__ void convert_weights(const KArgs& a, LAS unsigned char* lds, int wave, int lane, int gw, int NGW, bool late) {
    unsigned char* ws = a.ws;
    LAS float* scr = (LAS float*)(lds + wave * 16384);
    constexpr int I_POOL = (256 / 64) * (256 / 32), I_QKV = (DM / 64) * (NQKV / 32), I_O = (DM / 64) * (DM / 32), I_IN = (DM / 64) * (FF / 32), I_OUT = (FF / 64) * (DM / 32);
    if (!late) {
        for (int it = gw; it < 4 * I_POOL + I_IN + I_OUT; it += NGW) {
            int r = it;
            if (r < 4 * I_POOL) { const int g = r / I_POOL; p0_transpose_item(a.w_pool + (size_t)g * 65536, 256, 256, (bf16r*)(ws + WS_WPOOL), g * 256, scr, r % I_POOL, lane, a.pool_scale); continue; } r -= 4 * I_POOL;
            if (r < I_IN) { p0_transpose_item(a.w_mlp_in, DM, FF, (bf16r*)(ws + WS_WIN0), 0, scr, r, lane); continue; } r -= I_IN;
            p0_transpose_item(a.w_mlp_out, FF, DM, (bf16r*)(ws + WS_WOUT0), 0, scr, r, lane);
        }
    } else {
        for (int it = gw; it < I_QKV + I_O + I_IN + I_OUT; it += NGW) {
            int r = it;
            if (r < I_QKV) { p0_transpose_item(a.w_qkv, DM, NQKV, (bf16r*)(ws + WS_WQKV), 0, scr, r, lane); continue; } r -= I_QKV;
            if (r < I_O) { p0_transpose_item(a.w_o, DM, DM, (bf16r*)(ws + WS_WO), 0, scr, r, lane); continue; } r -= I_O;
            if (r < I_IN) { p0_transpose_item(a.w_mlp_in + (size_t)DM * FF, DM, FF, (bf16r*)(ws + WS_WIN1), 0, scr, r, lane); continue; } r -= I_IN;
            p0_transpose_item(a.w_mlp_out + (size_t)DM * FF, FF, DM, (bf16r*)(ws + WS_WOUT1), 0, scr, r, lane);
        }
    }
}

__device__ __forceinline__ void phase0(const KArgs& a, LAS unsigned char* lds, int tid, int lane, int wave) {
    unsigned char* ws = a.ws;
    float* mods = (float*)(ws + WS_MODS);
    for (int it = blockIdx.x; it < 96; it += gridDim.x) {
        const int layer = it / 48, nb = (it % 48) >> 1, kh = it & 1;
        LAS float* sil = (LAS float*)lds; LAS float* part = sil + 3072;
        for (int i = tid; i < 3072; i += NTHR) { const int s = i >> 10, k = i & 1023; const float v = s < 2 ? a.c[s * 1024 + k] : a.c_ctx[k]; sil[i] = v / (1.f + __expf(-v)); }
        __syncthreads();
        const float* W = a.w_ada + (size_t)layer * DM * MODW + nb * 256 + 4 * lane;
        f32x4 a0 = {0, 0, 0, 0}, a1 = {0, 0, 0, 0}, a2 = {0, 0, 0, 0};
        const int kbase = kh * 512 + wave * 64;
        for (int kb = 0; kb < 64; kb += 32) {
            f32x4 wv[32];
#pragma unroll
            for (int i = 0; i < 32; ++i) wv[i] = __builtin_nontemporal_load((const f32x4*)(W + (size_t)(kbase + kb + i) * MODW));
#pragma unroll
            for (int i = 0; i < 32; ++i) { const int k = kbase + kb + i; a0 += sil[k] * wv[i]; a1 += sil[1024 + k] * wv[i]; a2 += sil[2048 + k] * wv[i]; }
        }
#pragma unroll
        for (int e = 0; e < 4; ++e) { part[(wave * 3 + 0) * 256 + 4 * lane + e] = a0[e]; part[(wave * 3 + 1) * 256 + 4 * lane + e] = a1[e]; part[(wave * 3 + 2) * 256 + 4 * lane + e] = a2[e]; }
        __syncthreads();
        for (int i = tid; i < 768; i += NTHR) { const int s = i >> 8, n = i & 255; float sum = 0.f;
#pragma unroll
            for (int w = 0; w < 8; ++w) sum += part[(w * 3 + s) * 256 + n];
            if (kh == 0) sum += a.b_ada[layer * MODW + nb * 256 + n];
            atomicAdd(&mods[(layer * 3 + s) * MODW + nb * 256 + n], sum); }
        __syncthreads();
    }
    {
        LAS float* scr = (LAS float*)(lds + wave * 16384);
        const int gw = blockIdx.x * NWAVES + wave, NGW = gridDim.x * NWAVES;
        const bool many = gridDim.x > 192;
        if (!(many && blockIdx.x < 96)) convert_weights(a, lds, wave, lane, many ? ((int)blockIdx.x - 96) * NWAVES + wave : gw, many ? ((int)gridDim.x - 96) * NWAVES : NGW, false);
        float* rstd = (float*)(ws + WS_RSTD);
        for (int ch = gw; ch < MALL / 4; ch += NGW) {
            f32x4 v[4][4];
#pragma unroll
            for (int rr = 0; rr < 4; ++rr) { const int r = 4 * ch + rr; const float* xr = (r < MLAT ? a.x + (size_t)r * DM : a.ctx + (size_t)(r - MLAT) * DM) + 4 * lane;
#pragma unroll
                for (int j = 0; j < 4; ++j) v[rr][j] = __builtin_nontemporal_load((const f32x4*)(xr + 256 * j)); }
            float ss[4];
#pragma unroll
            for (int rr = 0; rr < 4; ++rr) { ss[rr] = 0.f;
#pragma unroll
                for (int j = 0; j < 4; ++j) ss[rr] += (v[rr][j].x * v[rr][j].x + v[rr][j].y * v[rr][j].y) + (v[rr][j].z * v[rr][j].z + v[rr][j].w * v[rr][j].w); }
#pragma unroll
            for (int o = 1; o < 64; o <<= 1) {
#pragma unroll
                for (int rr = 0; rr < 4; ++rr) ss[rr] += __shfl_xor(ss[rr], o); }
            if (lane < 4) { const float sv = lane == 0 ? ss[0] : lane == 1 ? ss[1] : lane == 2 ? ss[2] : ss[3]; rstd[4 * ch + lane] = 1.0f / sqrtf(sv * (1.0f / DM) + EPS); }
        }
    }
    {
        float* rc = (float*)(ws + WS_ROPE); float* rs = rc + 4096;
        for (int i = blockIdx.x * NTHR + tid; i < 4096; i += gridDim.x * NTHR) {
            const int p = i >> 5, f = i & 31;
            const float inv = (float)exp(-(double)f * (9.210340371976184 / 32.0));
            const float ang = (float)p * inv;
            const double ad = (double)ang, q = rint(ad * 0.6366197723675814);
            double r = fma(-q, 1.5707963267948966, ad); r = fma(-q, 6.123233995736766e-17, r);
            const double r2 = r * r;
            const double s = r * (1.0 + r2 * (-1.0 / 6 + r2 * (1.0 / 120 + r2 * (-1.0 / 5040 + r2 * (1.0 / 362880 + r2 * (-1.0 / 39916800 + r2 * (1.0 / 6227020800.0)))))));
            const double cc = 1.0 + r2 * (-0.5 + r2 * (1.0 / 24 + r2 * (-1.0 / 720 + r2 * (1.0 / 40320 + r2 * (-1.0 / 3628800 + r2 * (1.0 / 479001600.0 + r2 * (-1.0 / 87178291200.0)))))));
            const int qi = ((int)q) & 3;
            const double sn = qi == 0 ? s : qi == 1 ? cc : qi == 2 ? -s : -cc;
            const double cs = qi == 0 ? cc : qi == 1 ? -s : qi == 2 ? -cc : s;
            rc[i] = (float)cs; rs[i] = (float)sn;
        }
    }
}

template <int HW>
__device__ __forceinline__ void diff_run(const float* src, const float* rstd, int t0, int L, f32x4 gs, f32x4 sh, bf16r* dst, int lane) {
    constexpr int RUN = 16, NR = RUN + 2 * HW - 1;
    const int ti = t0 - HW + lane; const bool vi = (ti >= 0) && (ti < L) && (lane < NR);
    const float rl = vi ? rstd[ti] : 0.f;
    f32x4 h[NR];
#pragma unroll
    for (int i = 0; i < NR; ++i) { int tc = t0 - HW + i; tc = tc < 0 ? 0 : tc; tc = tc > L - 1 ? L - 1 : tc; h[i] = __builtin_nontemporal_load((const f32x4*)(src + (size_t)tc * DM)); }
#pragma unroll
    for (int i = 0; i < NR; ++i) { const float rs = __shfl(rl, i); h[i] = (h[i] * rs) * gs; }
    f32x4 S = {0.f, 0.f, 0.f, 0.f};
#pragma unroll
    for (int i = 0; i < 2 * HW - 1; ++i) S += h[i];
#pragma unroll
    for (int tt = 0; tt < RUN; ++tt) {
        S += h[tt + 2 * HW - 1];
        const int t = t0 + tt; const int lo = (t - HW) > 0 ? (t - HW) : 0, hi = (t + HW) < L ? (t + HW) : L;
        const float inv = 1.0f / (float)(hi - lo);
        const f32x4 d = (S * inv + sh) - (h[tt + HW] + sh);
        u32x2 o; o.x = pk2(d.x, d.y); o.y = pk2(d.z, d.w);
        *(u32x2*)(dst + (size_t)tt * DM) = o;
        S -= h[tt];
    }
}
__device__ __forceinline__ void phase_diff(const KArgs& a, int lane, int wave) {
    unsigned char* ws = a.ws;
    const float* mods = (const float*)(ws + WS_MODS);
    const float* rstd = (const float*)(ws + WS_RSTD);
    bf16r* diff = (bf16r*)(ws + WS_DIFF);
    const int gw = blockIdx.x * NWAVES + wave, NGW = gridDim.x * NWAVES;
    for (int it = gw; it < (MALL / 16) * 4; it += NGW) {
        const int g = it & 3, run = it >> 2, r0 = run * 16;
        const float* src; const float* rs; int t0, L, ms;
        if (r0 < MLAT) { const int b = r0 / SEQ; t0 = r0 % SEQ; L = SEQ; src = a.x + (size_t)b * SEQ * DM; rs = rstd + b * SEQ; ms = b; }
        else { const int rr = r0 - MLAT; const int b = rr / CTXL; t0 = rr % CTXL; L = CTXL; src = a.ctx + (size_t)b * CTXL * DM; rs = rstd + MLAT + b * CTXL; ms = 2; }
        const int col = g * 256 + 4 * lane;
        const f32x4 gpre = *(const f32x4*)(a.g_mix_pre + col);
        const f32x4 sh = *(const f32x4*)(mods + ms * MODW + 0 * DM + col);
        const f32x4 sc = *(const f32x4*)(mods + ms * MODW + 1 * DM + col);
        const f32x4 gs = gpre * (1.0f + sc);
        bf16r* dst = diff + (size_t)r0 * DM + col;
        src += col;
        if (g == 0) diff_run<1>(src, rs, t0, L, gs, sh, dst, lane);
        else if (g == 1) diff_run<2>(src, rs, t0, L, gs, sh, dst, lane);
        else if (g == 2) diff_run<4>(src, rs, t0, L, gs, sh, dst, lane);
        else diff_run<8>(src, rs, t0, L, gs, sh, dst, lane);
    }
}

template <bool FIRST, bool HAS_NEXT, bool CTXSPLIT = false>
__device__ __forceinline__ void phase_rows(const KArgs& a, int row_begin, int nrows, int CH, const float* mods_cur, int gate_ch, const float* g_post, const float* mods_nxt, int sh_ch, const float* g_pre, int lane, int wave) {
    unsigned char* ws = a.ws;
    bf16r* AY = (bf16r*)(ws + WS_AY); bf16r* XB = (bf16r*)(ws + WS_XB);
    const int gw = blockIdx.x * NWAVES + wave, NGW = gridDim.x * NWAVES;
#define RCOL(j) (512 * ((j) >> 1) + 8 * lane + 4 * ((j) & 1))
#define UNPK(V_, lo4, hi4) do { lo4 = (f32x4){bflo((V_).x), bfhi((V_).x), bflo((V_).y), bfhi((V_).y)}; hi4 = (f32x4){bflo((V_).z), bfhi((V_).z), bflo((V_).w), bfhi((V_).w)}; } while (0)
    for (int ch = gw; ch < nrows / CH; ch += NGW) {
        const int r0 = row_begin + ch * CH; const int ms = r0 < MLAT ? r0 / SEQ : 2;
        f32x4 gg[4], gs[4], sh[4];
#pragma unroll
        for (int j = 0; j < 4; ++j) { const int col = RCOL(j);
            gg[j] = *(const f32x4*)(mods_cur + ms * MODW + gate_ch * DM + col) * *(const f32x4*)(g_post + col);
            if (HAS_NEXT) { gs[j] = *(const f32x4*)(g_pre + col) * (1.0f + *(const f32x4*)(mods_nxt + ms * MODW + (sh_ch + 1) * DM + col)); sh[j] = *(const f32x4*)(mods_nxt + ms * MODW + sh_ch * DM + col); }
        }
        for (int rr = 0; rr < CH; rr += 2) {
            f32x4 xv[2][4], yv[2][4]; float ss[2], s2[2];
#pragma unroll
            for (int q = 0; q < 2; ++q) { const int r = r0 + rr + q;
                const float* xin = r < MLAT ? a.x + (size_t)r * DM : a.ctx + (size_t)(r - MLAT) * DM;
                const bf16r* ay = AY + (size_t)r * DM; ss[q] = 0.f;
#pragma unroll
                for (int jp = 0; jp < 2; ++jp) { const int c8 = 512 * jp + 8 * lane;
                    if (FIRST) { xv[q][2 * jp] = __builtin_nontemporal_load((const f32x4*)(xin + c8)); xv[q][2 * jp + 1] = __builtin_nontemporal_load((const f32x4*)(xin + c8 + 4)); }
                    else { const u32x4 xw = *(const u32x4*)(XB + (size_t)r * DM + c8); UNPK(xw, xv[q][2 * jp], xv[q][2 * jp + 1]); }
                    if (CTXSPLIT && r >= MLAT) {
#pragma unroll
                        for (int h = 0; h < 2; ++h) { const float* pp = (const float*)a.out + (size_t)(r - MLAT) * DM + c8 + 4 * h; f32x4 acc4 = *(const f32x4*)pp;
#pragma unroll
                            for (int ks = 1; ks < KSPLIT; ++ks) acc4 += *(const f32x4*)(pp + (size_t)ks * MCTX * DM);
                            yv[q][2 * jp + h] = acc4; } }
                    else { const u32x4 w = *(const u32x4*)(ay + c8); UNPK(w, yv[q][2 * jp], yv[q][2 * jp + 1]); } } }
#pragma unroll
            for (int q = 0; q < 2; ++q)
#pragma unroll
                for (int j = 0; j < 4; ++j) ss[q] += (yv[q][j].x * yv[q][j].x + yv[q][j].y * yv[q][j].y) + (yv[q][j].z * yv[q][j].z + yv[q][j].w * yv[q][j].w);
#pragma unroll
            for (int o = 1; o < 64; o <<= 1) { ss[0] += __shfl_xor(ss[0], o); ss[1] += __shfl_xor(ss[1], o); }
#pragma unroll
            for (int q = 0; q < 2; ++q) { const int r = r0 + rr + q;
                const float ry = 1.0f / sqrtf(ss[q] * (1.0f / DM) + EPS); s2[q] = 0.f;
#pragma unroll
                for (int j = 0; j < 4; ++j) { xv[q][j] = xv[q][j] + gg[j] * (yv[q][j] * ry);
                    s2[q] += (xv[q][j].x * xv[q][j].x + xv[q][j].y * xv[q][j].y) + (xv[q][j].z * xv[q][j].z + xv[q][j].w * xv[q][j].w); }
#pragma unroll
                for (int jp = 0; jp < 2; ++jp) { const int c8 = 512 * jp + 8 * lane; const f32x4 lo4 = xv[q][2 * jp], hi4 = xv[q][2 * jp + 1];
                    if (HAS_NEXT) { u32x4 xo; xo.x = pk2(lo4.x, lo4.y); xo.y = pk2(lo4.z, lo4.w); xo.z = pk2(hi4.x, hi4.y); xo.w = pk2(hi4.z, hi4.w); *(u32x4*)(XB + (size_t)r * DM + c8) = xo; }
                    else { *(f32x4*)(a.out + (size_t)r * DM + c8) = lo4; *(f32x4*)(a.out + (size_t)r * DM + c8 + 4) = hi4; } } }
            if (HAS_NEXT) {
#pragma unroll
                for (int o = 1; o < 64; o <<= 1) { s2[0] += __shfl_xor(s2[0], o); s2[1] += __shfl_xor(s2[1], o); }
#pragma unroll
                for (int q = 0; q < 2; ++q) { const int r = r0 + rr + q; bf16r* ay = AY + (size_t)r * DM;
                    const float rx = 1.0f / sqrtf(s2[q] * (1.0f / DM) + EPS);
#pragma unroll
                    for (int jp = 0; jp < 2; ++jp) { const int c8 = 512 * jp + 8 * lane;
                        const f32x4 a0 = (xv[q][2 * jp] * rx) * gs[2 * jp] + sh[2 * jp], a1 = (xv[q][2 * jp + 1] * rx) * gs[2 * jp + 1] + sh[2 * jp + 1];
                        u32x4 o; o.x = pk2(a0.x, a0.y); o.y = pk2(a0.z, a0.w); o.z = pk2(a1.x, a1.y); o.w = pk2(a1.z, a1.w); *(u32x4*)(ay + c8) = o; } }
            }
        }
    }
#undef RCOL
#undef UNPK
}

__device__ __forceinline__ void phase_qknorm(const KArgs& a, int lane, int wave) {
    unsigned char* ws = a.ws;
    bf16r* Q = (bf16r*)(ws + WS_Q); bf16r* Kb = (bf16r*)(ws + WS_K);
    const float* rc = (const float*)(ws + WS_ROPE); const float* rsn = rc + 4096;
    const int gw = blockIdx.x * NWAVES + wave, NGW = gridDim.x * NWAVES;
    const int i0 = 4 * (lane & 31);
    const int f0 = i0 & 31; const bool first_half = i0 < 64; const bool lower = (i0 & 32) == 0;
    const f32x4 gq = *(const f32x4*)(a.g_q + i0), gk = *(const f32x4*)(a.g_k + i0);
    for (int it = gw; it < NBATCH * SKV / 8; it += NGW) {
        u32x2 w[8]; f32x4 cs[8], sn[8];
#pragma unroll
        for (int q = 0; q < 8; ++q) { const int kr = 8 * it + q; const int key = kr % SKV; const bool rope = key >= CTXL; const int t = rope ? key - CTXL : 0; const int p = first_half ? (t >> 6) : (t & 63);
            cs[q] = *(const f32x4*)(rc + p * 32 + f0); sn[q] = *(const f32x4*)(rsn + p * 32 + f0);
            if (!rope) { cs[q] = (f32x4){1.f, 1.f, 1.f, 1.f}; sn[q] = (f32x4){0.f, 0.f, 0.f, 0.f}; }
            w[q] = *(const u32x2*)(Kb + (size_t)kr * 256 + 4 * lane); }
        f32x4 v[8]; float ss[8];
#pragma unroll
        for (int q = 0; q < 8; ++q) { v[q] = (f32x4){bflo(w[q].x), bfhi(w[q].x), bflo(w[q].y), bfhi(w[q].y)}; ss[q] = (v[q].x * v[q].x + v[q].y * v[q].y) + (v[q].z * v[q].z + v[q].w * v[q].w); }
#pragma unroll
        for (int o = 1; o < 32; o <<= 1)
#pragma unroll
            for (int q = 0; q < 8; ++q) ss[q] += __shfl_xor(ss[q], o);
#pragma unroll
        for (int q = 0; q < 8; ++q) { const float rn = 1.0f / sqrtf(ss[q] * (1.0f / 128.0f) + EPS);
            const f32x4 vn = (v[q] * rn) * gk;
            f32x4 pv; pv.x = __shfl_xor(vn.x, 8); pv.y = __shfl_xor(vn.y, 8); pv.z = __shfl_xor(vn.z, 8); pv.w = __shfl_xor(vn.w, 8);
            const f32x4 o4 = lower ? (vn * cs[q] - pv * sn[q]) : (vn * cs[q] + pv * sn[q]);
            u32x2 o; o.x = pk2(o4.x, o4.y); o.y = pk2(o4.z, o4.w);
            *(u32x2*)(Kb + (size_t)(8 * it + q) * 256 + 4 * lane) = o; }
    }
}

#define XB_TMO      128
#define XB_XCNT(j)  (256  + 64 * (j))
#define XB_XSUB(j)  (1280 + 64 * (j))
#define XB_XGEN(j)  (2304 + 64 * (j))
#define XB_TOP      3328
#define XB_TOPGEN   3392
#define XCD_BAR_WORDS 3456
#define XB_SPIN_CAP (1u << 18)

__device__ __forceinline__ unsigned xb_ld(unsigned* p)              { return __hip_atomic_load(p, __ATOMIC_RELAXED, __HIP_MEMORY_SCOPE_AGENT); }
__device__ __forceinline__ unsigned xb_add(unsigned* p, unsigned v) { return __hip_atomic_fetch_add(p, v, __ATOMIC_RELAXED, __HIP_MEMORY_SCOPE_AGENT); }
__device__ __forceinline__ unsigned xb_xcc_id() { return (unsigned)__builtin_amdgcn_s_getreg((3 << 11) | 20) & 0xFu; }
#define XB_SPIN(cond, bar) do { unsigned _sp = 0; while (cond) { __builtin_amdgcn_s_sleep(1); \
    if ((++_sp & 255u) == 0u) { if (xb_ld(&(bar)[XB_TMO])) break; if (_sp > XB_SPIN_CAP) { atomicAdd(&(bar)[XB_TMO], 1u); break; } } } } while (0)

struct XcdBarrier {
    unsigned* bar; unsigned x;
    volatile LAS unsigned* st;
};

__device__ __forceinline__ XcdBarrier xcd_barrier_post(unsigned* bar, volatile LAS unsigned* st) {
    XcdBarrier b; b.bar = bar; b.x = xb_xcc_id(); b.st = st;
    if (threadIdx.x == 0) (void)xb_add(&bar[XB_XCNT(b.x)], 1u);
    return b;
}
__device__ __forceinline__ void xcd_barrier_complete(unsigned* bar, unsigned x, unsigned& nloc, unsigned& nx) {
    const unsigned G = gridDim.x * gridDim.y * gridDim.z;
    unsigned sum, cnt, mine, sp = 0u;
    for (;;) {
        sum = 0u; cnt = 0u; mine = 0u;
#pragma unroll
        for (unsigned j = 0; j < 16; ++j) { const unsigned c = xb_ld(&bar[XB_XCNT(j)]); sum += c; cnt += (c > 0u) ? 1u : 0u; mine = (j == x) ? c : mine; }
        if (sum == G) break;
        __builtin_amdgcn_s_sleep(1);
        if ((++sp & 255u) == 0u) { if (xb_ld(&bar[XB_TMO])) break; if (sp > XB_SPIN_CAP) { atomicAdd(&bar[XB_TMO], 1u); break; } }
    }
    nloc = mine > 0u ? mine : 1u; nx = cnt > 0u ? cnt : 1u;
}

__device__ __forceinline__ void xcd_barrier(const XcdBarrier& b) {
    asm volatile("s_waitcnt vmcnt(0)" ::: "memory");
    __syncthreads();
    if (threadIdx.x == 0) {
        unsigned* bar = b.bar;
        __builtin_amdgcn_s_waitcnt(0);
        unsigned nloc = b.st[0], nx = b.st[1];
        if (nloc == 0u) { xcd_barrier_complete(bar, b.x, nloc, nx); b.st[0] = nloc; b.st[1] = nx; }
        const unsigned old = xb_add(&bar[XB_XSUB(b.x)], 1u);
        const unsigned gen = old / nloc;
        if (old + 1u == (gen + 1u) * nloc) {
            __builtin_amdgcn_fence(__ATOMIC_RELEASE, "agent");
            asm volatile("s_waitcnt vmcnt(0)" ::: "memory");
            const unsigned og = xb_add(&bar[XB_TOP], 1u);
            const unsigned tg = og / nx;
            if (og + 1u == (tg + 1u) * nx) xb_add(&bar[XB_TOPGEN], 1u);
            else XB_SPIN(xb_ld(&bar[XB_TOPGEN]) == tg, bar);
            __builtin_amdgcn_fence(__ATOMIC_ACQUIRE, "agent");
            xb_add(&bar[XB_XGEN(b.x)], 1u);
            asm volatile("s_waitcnt vmcnt(0)" ::: "memory");
        } else {
            XB_SPIN(xb_ld(&bar[XB_XGEN(b.x)]) == gen, bar);
            __builtin_amdgcn_fence(__ATOMIC_ACQUIRE, "agent");
            asm volatile("s_waitcnt vmcnt(0)" ::: "memory");
        }
    }
    __syncthreads();
}

__global__ void __launch_bounds__(NTHR, 2) fwd_megakernel(KArgs a) {
    extern __shared__ __attribute__((aligned(16))) unsigned char lds_raw[];
    LAS unsigned char* lds = (LAS unsigned char*)lds_raw;
    __builtin_assume(__builtin_amdgcn_workitem_id_y() == 0); __builtin_assume(__builtin_amdgcn_workitem_id_z() == 0);
    cg::grid_group grid = cg::this_grid();
    const int tid = threadIdx.x, lane = tid & 63, wave = __builtin_amdgcn_readfirstlane(tid >> 6);
    unsigned char* ws = a.ws;
    const int lo = a.ph_lo, hi = a.ph_hi;
    const float* mods0 = (const float*)(ws + WS_MODS); const float* mods1 = mods0 + 3 * MODW;
    bf16r* AY = (bf16r*)(ws + WS_AY); bf16r* HB = (bf16r*)(ws + WS_H);
    volatile LAS unsigned* MISC = (volatile LAS unsigned*)(lds + RING_BYTES + 64);
    if (tid < 2) MISC[tid] = 0u;
    __syncthreads();
    XcdBarrier bar = xcd_barrier_post((unsigned*)(ws + WS_CTL) + 4096, MISC);
#define IN(k) (lo <= (k) && (k) < hi)
#define SEAM(k) do { if (IN(k) && IN((k) + 1)) xcd_barrier(bar); } while (0)
    if (hi < 0) grid.sync();

    if (IN(0)) { phase0(a, lds, tid, lane, wave); } SEAM(0);
    if (IN(1)) { phase_diff(a, lane, wave); } SEAM(1);
    if (IN(2)) {
        pg8::Gemm g{(const pg8::bf16_t*)(ws + WS_DIFF), (const pg8::bf16_t*)(ws + WS_WPOOL), MALL, DM, 256, DM, 256, 1, 1 << 20, 256 * 2, 0}; pg8::StaticOrder S; S.init(MALL, DM, gridDim.x, blockIdx.x);
        pg8::EpiStore<0> E{AY, DM, nullptr};
        pg8::gemm_phase<pg8::EpiStore<0>, pg8::StaticOrder, true, true>(lds, g, S, E);
    } SEAM(2);
    if (IN(3)) { phase_rows<true, true>(a, 0, MLAT, 8, mods0, 2, a.g_mix_post, mods0, 3, a.g_mlp_pre, lane, wave); phase_rows<true, true>(a, MLAT, MCTX, 2, mods0, 2, a.g_mix_post, mods0, 3, a.g_mlp_pre, lane, wave); } SEAM(3);
    if (IN(4)) {
        pg8::Gemm g{AY, (const pg8::bf16_t*)(ws + WS_WIN0), MALL, FF, DM, DM, DM, 1, 1 << 20, 0, 0}; pg8::StaticOrder S; S.init(MALL, FF, gridDim.x, blockIdx.x);
        pg8::EpiStore<1> E{HB, FF, nullptr};
        pg8::gemm_phase<pg8::EpiStore<1>, pg8::StaticOrder, true, true>(lds, g, S, E);
        { const bool many = gridDim.x > 64; __syncthreads();
          if (!(many && blockIdx.x < 32)) convert_weights(a, lds, wave, lane, many ? ((int)blockIdx.x - 32) * NWAVES + wave : (int)blockIdx.x * NWAVES + wave, many ? ((int)gridDim.x - 32) * NWAVES : (int)gridDim.x * NWAVES, true); }
    } SEAM(4);
    if (IN(5)) {
        pg8::Gemm g{HB, (const pg8::bf16_t*)(ws + WS_WOUT0), MLAT, DM, FF, FF, FF, 1, 1 << 20, 0, 0}; pg8::StaticOrder S; S.init(MLAT, DM, gridDim.x, blockIdx.x);
        pg8::EpiStore<0> E{AY, DM, nullptr};
        pg8::gemm_phase<pg8::EpiStore<0>, pg8::StaticOrder, true, true>(lds, g, S, E);
        pg8::Gemm g2{HB + (size_t)MLAT * FF, (const pg8::bf16_t*)(ws + WS_WOUT0), MCTX, DM * KSPLIT, FF / KSPLIT, FF, FF, 4, 4, (size_t)(FF / KSPLIT) * 2, (size_t)(FF / KSPLIT) * 2};
        pg8::StaticOrder S2; S2.init(MCTX, DM * KSPLIT, gridDim.x, blockIdx.x);
        pg8::EpiPart E2{a.out};
        pg8::gemm_phase<pg8::EpiPart, pg8::StaticOrder, true, true>(lds, g2, S2, E2);
    } SEAM(5);
    if (IN(6)) { phase_rows<false, true, true>(a, 0, MLAT, 8, mods0, 5, a.g_mlp_post, mods1, 0, a.g_mix_pre + DM, lane, wave); phase_rows<false, true, true>(a, MLAT, MCTX, 2, mods0, 5, a.g_mlp_post, mods1, 0, a.g_mix_pre + DM, lane, wave); } SEAM(6);
    if (IN(7)) {
        pg8::Gemm g{AY, (const pg8::bf16_t*)(ws + WS_WQKV), MALL, NQKV, DM, DM, DM, 1, 1 << 20, 0, 0}; pg8::StaticOrder S; S.init(MALL, NQKV, gridDim.x, blockIdx.x);
        pg8::EpiQKV E{(pg8::bf16_t*)(ws + WS_Q), (pg8::bf16_t*)(ws + WS_K), (pg8::bf16_t*)(ws + WS_V), SKV, SEQ / 256, a.g_k, (const float*)(ws + WS_ROPE), (const float*)(ws + WS_ROPE) + 4096, (LAS float*)(lds + RING_BYTES + 1024), EPS};
        pg8::gemm_phase<pg8::EpiQKV, pg8::StaticOrder, true, true>(lds, g, S, E);
    } SEAM(7);
    if (IN(9)) {
        const int G = gridDim.x, bx = blockIdx.x; const int vcu = (G % 8 == 0) ? (bx % 8) * (G / 8) + bx / 8 : bx;
        const int upb = (512 + G - 1) / G;
        const att::bf16* Q = (const att::bf16*)(ws + WS_Q); const att::bf16* Kb = (const att::bf16*)(ws + WS_K); const att::bf16* Vb = (const att::bf16*)(ws + WS_V); att::bf16* O = (att::bf16*)(ws + WS_O);
        float gqm = fmaxf(fabsf(a.g_q[lane]), fabsf(a.g_q[lane + 64])), gkm = fmaxf(fabsf(a.g_k[lane]), fabsf(a.g_k[lane + 64]));
#pragma unroll
        for (int o = 1; o < 64; o <<= 1) { gqm = fmaxf(gqm, __shfl_xor(gqm, o)); gkm = fmaxf(gkm, __shfl_xor(gkm, o)); }
        const float mC = __uint_as_float(__builtin_amdgcn_readfirstlane(__float_as_uint(128.0f * gqm * gkm * (att::SCALE * 1.4426950408889634f))));
        for (int i = 0; i < upb; ++i) {
            const int unit = vcu * upb + i; if (unit >= 512) break;
            const int grp = unit >> 7, rem = unit & 127, gq = rem >> 5, qb = rem & 31, b = grp >> 1, kvh = grp & 1, h = kvh * 4 + gq;
            const size_t qoff = ((size_t)(b * SEQ + qb * 256)) * DM + h * 128, koff = (size_t)b * SKV * 256 + kvh * 128;
            att::attn_dense_body<att::bf16>(Q + qoff, Kb + koff, Vb + koff, O + qoff, SKV, (char*)lds_raw, mC, a.g_q, (const float*)(ws + WS_ROPE), (const float*)(ws + WS_ROPE) + 4096, qb * 256);
            __syncthreads();
        }
    } SEAM(9);
    if (IN(10)) {
        pg8::Gemm g{(const pg8::bf16_t*)(ws + WS_O), (const pg8::bf16_t*)(ws + WS_WO), MLAT, DM, DM, DM, DM, 1, 1 << 20, 0, 0}; pg8::StaticOrder S; S.init(MLAT, DM, gridDim.x, blockIdx.x);
        pg8::EpiStore<0> E{AY, DM, nullptr};
        pg8::gemm_phase<pg8::EpiStore<0>, pg8::StaticOrder, true, true>(lds, g, S, E);
    } SEAM(10);
    if (IN(11)) { phase_rows<false, true>(a, 0, MLAT, 8, mods1, 2, a.g_mix_post + DM, mods1, 3, a.g_mlp_pre + DM, lane, wave); } SEAM(11);
    if (IN(12)) {
        pg8::Gemm g{AY, (const pg8::bf16_t*)(ws + WS_WIN1), MLAT, FF, DM, DM, DM, 1, 1 << 20, 0, 0}; pg8::StaticOrder S; S.init(MLAT, FF, gridDim.x, blockIdx.x);
        pg8::EpiStore<1> E{HB, FF, nullptr};
        pg8::gemm_phase<pg8::EpiStore<1>, pg8::StaticOrder, true, true>(lds, g, S, E);
    } SEAM(12);
    if (IN(13)) {
        pg8::Gemm g{HB, (const pg8::bf16_t*)(ws + WS_WOUT1), MLAT, DM, FF, FF, FF, 1, 1 << 20, 0, 0}; pg8::StaticOrder S; S.init(MLAT, DM, gridDim.x, blockIdx.x);
        pg8::EpiStore<0> E{AY, DM, nullptr};
        pg8::gemm_phase<pg8::EpiStore<0>, pg8::StaticOrder, true, true>(lds, g, S, E);
    } SEAM(13);
    if (IN(14)) { phase_rows<false, false>(a, 0, MLAT, 8, mods1, 5, a.g_mlp_post + DM, mods1, 0, a.g_mix_pre, lane, wave); }
#undef IN
#undef SEAM
}

#ifndef MK_MULTI
#define MK_MULTI 0
#endif
constexpr int NPHASES = 15;
extern "C" void kernel_launch(void* const* d_in, const int* in_sizes, int n_in, void* d_out, int out_size, void* d_ws, size_t ws_size, hipStream_t stream) {
    static int grid = 0;
    if (grid == 0) {
        if (n_in != 18 || in_sizes[0] != MLAT * DM || out_size != MLAT * DM || ws_size < WS_END) { fprintf(stderr, "kernel_launch: unexpected shapes (n_in %d in0 %d out %d ws %zu)\n", n_in, n_in > 0 ? in_sizes[0] : -1, out_size, ws_size); grid = -1; return; }
        int dev = 0, cus = 0, per_cu = 0;
        hipGetDevice(&dev); hipDeviceGetAttribute(&cus, hipDeviceAttributeMultiprocessorCount, dev);
        if (hipFuncSetAttribute((const void*)fwd_megakernel, hipFuncAttributeMaxDynamicSharedMemorySize, LDS_BYTES) != hipSuccess) { fprintf(stderr, "kernel_launch: hipFuncSetAttribute failed\n"); grid = -1; return; }
        if (hipOccupancyMaxActiveBlocksPerMultiprocessor(&per_cu, (const void*)fwd_megakernel, NTHR, LDS_BYTES) != hipSuccess || per_cu < 1) { fprintf(stderr, "kernel_launch: occupancy query says %d\n", per_cu); per_cu = 1; }
        (void)hipGetLastError();
        grid = cus * 1;
        fprintf(stderr, "kernel_launch: grid %d (cus %d, per_cu %d)\n", grid, cus, per_cu);
    }
    if (grid < 0) return;
    KArgs a{};
    const float** pp = (const float**)&a;
    for (int i = 0; i < 18; ++i) pp[i] = (const float*)d_in[i];
    a.out = (float*)d_out; a.ws = (unsigned char*)d_ws;
    if (hipMemsetAsync((char*)d_ws + WS_CTL, 0, WS_MODS + 144 * 1024, stream) != hipSuccess) { fprintf(stderr, "kernel_launch: memset of the control words failed\n"); return; }
#if MK_MULTI
    for (int p = 0; p < NPHASES; ++p) { a.ph_lo = p; a.ph_hi = p + 1;
        int reps = 1;
        if (MK_MULTI == 2 && (p == 2 || p == 4 || p == 5 || p == 7 || p == 10 || p == 12 || p == 13)) reps = 2;
        if (MK_MULTI == 3 && p == 9) reps = 2;
        if (MK_MULTI == 4 && (p == 0 || p == 1 || p == 8)) reps = 2;
        for (int r = 0; r < reps; ++r) hipLaunchKernelGGL(fwd_megakernel, dim3(grid), dim3(NTHR), LDS_BYTES, stream, a); }
#else
    a.ph_lo = 0; a.ph_hi = NPHASES;
    void* args[] = {&a};
    hipError_t e = hipLaunchCooperativeKernel((const void*)fwd_megakernel, dim3(grid), dim3(NTHR), args, LDS_BYTES, stream);
    if (e != hipSuccess) fprintf(stderr, "cooperative launch failed: %s (grid %d)\n", hipGetErrorString(e), grid);
#endif
}
```

```cpp
#include <hip/hip_runtime.h>
#include <hip/hip_bf16.h>
#include <hip/hip_cooperative_groups.h>
#include <cstdio>
#include <cstdint>
namespace cg = cooperative_groups;

namespace pg8 {
#define PG8_LAS __attribute__((address_space(3)))
typedef unsigned short bf16_t;
typedef short bf16x8 __attribute__((ext_vector_type(8)));
typedef float f32x4 __attribute__((ext_vector_type(4)));
typedef unsigned u32x4 __attribute__((ext_vector_type(4)));
constexpr int BM = 256, BK = 64, HALF = 128, HTB = HALF * BK * 2  , STAGE_BYTES = 8 * HTB, NXCD = 8, WGM = 8;

__host__ __device__ __forceinline__ int lds_byte(int r, int c) { const int st = (r >> 4) * 2 + (c >> 5), rr = r & 15, cc = c & 31, ob = rr * 64 + cc * 2; return st * 1024 + (ob ^ (((ob >> 9) & 1) << 5)); }
__host__ __device__ __forceinline__ void stage_rc(int b, int& R, int& C) { const int st = b / 1024, sb = b % 1024, swz = sb ^ (((sb >> 9) & 1) << 5); R = (st >> 1) * 16 + swz / 64; C = (st & 1) * 32 + (swz % 64) / 2; }
__host__ __device__ __forceinline__ int perm32(int rho) { const int n = rho >> 4, i = rho & 15; return 8 * (i >> 2) + 4 * n + (i & 3); }

struct Unit { int pm, pn; };
struct Gemm { const bf16_t* A; const bf16_t* Bt; int M, N, K, lda, ldb, adiv, bmod; size_t a_step, b_step; };

struct StaticOrder {
    int nM, nN, nwg, G, c;
    __host__ __device__ void init(int M, int N, int G_, int c_) { nM = M / BM; nN = N / BM; nwg = nM * nN; G = G_; c = c_; }
    __host__ __device__ bool next(int i, Unit& u) const {
        const long L = (long)i * G + c; if (L >= nwg) return false;
        int wgid = (int)L; { const int q = nwg / NXCD, r = nwg % NXCD, xcd = wgid % NXCD, off = wgid / NXCD; wgid = (xcd < r ? xcd * (q + 1) : r * (q + 1) + (xcd - r) * q) + off; }
        const int nig = WGM * nN, gid = wgid / nig, fm = gid * WGM, gsz = (nM - fm) < WGM ? (nM - fm) : WGM;
        u.pm = fm + ((wgid % nig) % gsz); u.pn = (wgid % nig) / gsz; return true;
    }
    __device__ __forceinline__ void a_ready(const Unit&) const {}
    __device__ __forceinline__ void done(const Unit&) const {}
};

__device__ __forceinline__ unsigned cvt_pk_bf16(float lo, float hi) { unsigned r; asm volatile("v_cvt_pk_bf16_f32 %0, %1, %2" : "=v"(r) : "v"(lo), "v"(hi)); return r; }
template <int ACT> struct EpiStore {
    static constexpr bool PERM = true, PERM2 = false, AFTER_DRAIN = false;
    bf16_t* O; int ldc; const float* cs;
    __device__ __forceinline__ void operator()(const f32x4 (&acc)[2][2][4][2], const Unit& u, int wr, int wc, int fr, int fq) const {
        const int row0 = u.pm * BM + wr * 64 + fr; const int col0 = u.pn * BM + wc * 32 + 8 * fq;
        f32x4 sv[2][2];
#pragma unroll
        for (int bj = 0; bj < 2; ++bj)
#pragma unroll
            for (int n = 0; n < 2; ++n) sv[bj][n] = (ACT == 2) ? *(const f32x4*)(cs + col0 + bj * HALF + 4 * n) : (f32x4){1.f, 1.f, 1.f, 1.f};
#pragma unroll
        for (int ai = 0; ai < 2; ++ai)
#pragma unroll
            for (int m = 0; m < 4; ++m) { bf16_t* rowp = O + (size_t)(row0 + ai * HALF + m * 16) * ldc + col0;
#pragma unroll
                for (int bj = 0; bj < 2; ++bj) { f32x4 v0 = acc[ai][bj][m][0], v1 = acc[ai][bj][m][1];
                    if (ACT == 1) { v0 = __builtin_elementwise_max(v0, (f32x4){0.f, 0.f, 0.f, 0.f}); v1 = __builtin_elementwise_max(v1, (f32x4){0.f, 0.f, 0.f, 0.f}); v0 = v0 * v0; v1 = v1 * v1; }
                    if (ACT == 2) { v0 = v0 * sv[bj][0]; v1 = v1 * sv[bj][1]; }
                    u32x4 w; w.x = cvt_pk_bf16(v0[0], v0[1]); w.y = cvt_pk_bf16(v0[2], v0[3]); w.z = cvt_pk_bf16(v1[0], v1[1]); w.w = cvt_pk_bf16(v1[2], v1[3]);
                    *(u32x4*)(rowp + bj * HALF) = w; } }
    }
};
struct EpiPart {
    static constexpr bool PERM = true, PERM2 = false, AFTER_DRAIN = false;
    float* P;
    __device__ __forceinline__ void operator()(const f32x4 (&acc)[2][2][4][2], const Unit& u, int wr, int wc, int fr, int fq) const {
        const int ks = u.pn >> 2, ct = u.pn & 3;
        const int row0 = u.pm * BM + wr * 64 + fr; const int col0 = ct * BM + wc * 32 + 8 * fq;
        float* base = P + (size_t)ks * 512 * 1024;
#pragma unroll
        for (int ai = 0; ai < 2; ++ai)
#pragma unroll
            for (int m = 0; m < 4; ++m) { float* rowp = base + (size_t)(row0 + ai * HALF + m * 16) * 1024 + col0;
#pragma unroll
                for (int bj = 0; bj < 2; ++bj) { *(f32x4*)(rowp + bj * HALF) = acc[ai][bj][m][0]; *(f32x4*)(rowp + bj * HALF + 4) = acc[ai][bj][m][1]; } }
    }
};
struct EpiQKV {
    static constexpr bool PERM = true, PERM2 = true, AFTER_DRAIN = false;
    bf16_t* Q; bf16_t* Kb; bf16_t* Vb; int skv, seq_tiles;
    const float* gk; const float* rc; const float* rsn; PG8_LAS float* P; float eps;
    __device__ __forceinline__ void operator()(const f32x4 (&acc)[2][2][4][2], const Unit& u, int wr, int wc, int fr, int fq) const {
        bf16_t* base; int ldc, rowbase, colt;
        const int nlat = 2 * seq_tiles;
        if (u.pn < 4) { base = Q; ldc = 1024; rowbase = u.pm * BM; colt = u.pn * BM; }
        else { base = (u.pn == 4) ? Kb : Vb; ldc = 256; colt = 0;
               rowbase = (u.pm < nlat) ? (u.pm / seq_tiles) * skv + 256 + (u.pm % seq_tiles) * 256 : (u.pm - nlat) * skv; }
        const int hb = 64 * (wc & 1);
        const int col0 = colt + 128 * (wc >> 1) + hb + 8 * fq;
        if (u.pn != 4) {
#pragma unroll
            for (int ai = 0; ai < 2; ++ai)
#pragma unroll
                for (int m = 0; m < 4; ++m) { bf16_t* rowp = base + (size_t)(rowbase + wr * 64 + fr + ai * HALF + m * 16) * ldc + col0;
#pragma unroll
                    for (int n = 0; n < 2; ++n) { const f32x4 v0 = acc[ai][0][m][n], v1 = acc[ai][1][m][n];
                        u32x4 w; w.x = cvt_pk_bf16(v0[0], v0[1]); w.y = cvt_pk_bf16(v0[2], v0[3]); w.z = cvt_pk_bf16(v1[0], v1[1]); w.w = cvt_pk_bf16(v1[2], v1[3]);
                        *(u32x4*)(rowp + 32 * n) = w; } }
            return;
        }
#pragma unroll
        for (int ai = 0; ai < 2; ++ai)
#pragma unroll
            for (int m = 0; m < 4; ++m) { float q = 0.f;
#pragma unroll
                for (int bj = 0; bj < 2; ++bj)
#pragma unroll
                    for (int n = 0; n < 2; ++n) { const f32x4 x = acc[ai][bj][m][n]; q += (x[0] * x[0] + x[1] * x[1]) + (x[2] * x[2] + x[3] * x[3]); }
                q += __shfl_xor(q, 16); q += __shfl_xor(q, 32);
                if (fq == 0) P[(ai * HALF + wr * 64 + m * 16 + fr) * 4 + wc] = q; }
        asm volatile("s_waitcnt lgkmcnt(0)" ::: "memory"); __builtin_amdgcn_s_barrier(); asm volatile("" ::: "memory");
        const bool lat = u.pm < nlat; const int tbase = lat ? (u.pm % seq_tiles) * 256 : 0;
        f32x4 g0[2], g1[2];
#pragma unroll
        for (int bj = 0; bj < 2; ++bj) { g0[bj] = *(const f32x4*)(gk + hb + 8 * fq + 4 * bj); g1[bj] = *(const f32x4*)(gk + hb + 32 + 8 * fq + 4 * bj); }
        typedef float f32x2_t __attribute__((ext_vector_type(2)));
#pragma unroll
        for (int ai = 0; ai < 2; ++ai)
#pragma unroll
            for (int m = 0; m < 4; ++m) { const int r = ai * HALF + wr * 64 + m * 16 + fr;
                const f32x2_t pp = *(const PG8_LAS f32x2_t*)(P + r * 4 + 2 * (wc >> 1));
                const float rn = 1.0f / sqrtf((pp[0] + pp[1]) * (1.0f / 128.0f) + eps);
                int p = 0; if (lat) { const int t = tbase + r; p = ((wc & 1) == 0) ? (t >> 6) : (t & 63); }
                u32x4 w1, w2;
#pragma unroll
                for (int bj = 0; bj < 2; ++bj) {
                    f32x4 cs = {1.f, 1.f, 1.f, 1.f}, sn = {0.f, 0.f, 0.f, 0.f};
                    if (lat) { cs = *(const f32x4*)(rc + p * 32 + 8 * fq + 4 * bj); sn = *(const f32x4*)(rsn + p * 32 + 8 * fq + 4 * bj); }
                    const f32x4 x1 = (acc[ai][bj][m][0] * rn) * g0[bj], x2 = (acc[ai][bj][m][1] * rn) * g1[bj];
                    const f32x4 o1 = x1 * cs - x2 * sn, o2 = x2 * cs + x1 * sn;
                    if (bj == 0) { w1.x = cvt_pk_bf16(o1[0], o1[1]); w1.y = cvt_pk_bf16(o1[2], o1[3]); w2.x = cvt_pk_bf16(o2[0], o2[1]); w2.y = cvt_pk_bf16(o2[2], o2[3]); }
                    else         { w1.z = cvt_pk_bf16(o1[0], o1[1]); w1.w = cvt_pk_bf16(o1[2], o1[3]); w2.z = cvt_pk_bf16(o2[0], o2[1]); w2.w = cvt_pk_bf16(o2[2], o2[3]); } }
                bf16_t* rowp = base + (size_t)(rowbase + r) * ldc + col0;
                *(u32x4*)(rowp) = w1; *(u32x4*)(rowp + 32) = w2; }
    }
};
template <class Epi, class Sched, bool ALIGN_EPI = false, bool SP2 = false>
__device__ __forceinline__ void gemm_phase(PG8_LAS unsigned char* lds, const Gemm g, const Sched& S, const Epi& E) {
    const int tid = threadIdx.x, wid = __builtin_amdgcn_readfirstlane(tid >> 6), lane = tid & 63, wr = wid >> 2, wc = wid & 3, fr = lane & 15, fq = lane >> 4;
    const int K = g.K, nt = K / BK;
    unsigned voffA[2], voffB[2];
#pragma unroll
    for (int i = 0; i < 2; ++i) { int R, C; stage_rc(tid * 16 + i * 8192, R, C); const int Rb = Epi::PERM2 ? (128 * ((R >> 6) & 1) + 64 * ((R >> 5) & 1) + 32 * ((R >> 4) & 1) + 8 * ((R & 15) >> 2) + (R & 3)) : (Epi::PERM ? ((R & ~31) + perm32(R & 31)) : R);
        voffA[i] = (unsigned)(R * g.lda + C) * 2u; voffB[i] = (unsigned)(Rb * g.ldb + C) * 2u; }
    const size_t kstep = (size_t)(BK * 2);
    const size_t hstepA = (size_t)HALF * g.lda * 2, hstepB = Epi::PERM2 ? (size_t)4 * g.ldb * 2 : (size_t)HALF * g.ldb * 2;
    const size_t tstepA = 2 * hstepA, tstepB = (size_t)2 * HALF * g.ldb * 2;
    const unsigned ldsw = (unsigned)wid * 1024u;
    const int aoff = lds_byte(wr * 64 + fr, fq * 8), boff = lds_byte(wc * 32 + fr, fq * 8);
#define PG8_SA(b, h) (((b) * 2 + (h)) * HTB)
#define PG8_SB(b, h) ((4 + (b) * 2 + (h)) * HTB)
#define PG8_STAGE(bufoff, gbase, voff) do { _Pragma("unroll") for (int _i = 0; _i < 2; ++_i) \
        __builtin_amdgcn_global_load_lds((const unsigned*)((const char*)(gbase) + (voff)[_i]), (PG8_LAS unsigned*)(lds + (bufoff) + ldsw + _i * 8192), 16, 0, 0); } while (0)
#define PG8_LDA(dst, b, h) do { _Pragma("unroll") for (int m = 0; m < 4; ++m) _Pragma("unroll") for (int k = 0; k < 2; ++k) dst[m][k] = *(const PG8_LAS bf16x8*)(lds + PG8_SA(b, h) + aoff + m * 2048 + k * 1024); } while (0)
#define PG8_LDB(dst, b, h) do { _Pragma("unroll") for (int n = 0; n < 2; ++n) _Pragma("unroll") for (int k = 0; k < 2; ++k) dst[n][k] = *(const PG8_LAS bf16x8*)(lds + PG8_SB(b, h) + boff + n * 2048 + k * 1024); } while (0)
#define PG8_MMA(ai, bj, At, Bt) do { __builtin_amdgcn_s_setprio(1); _Pragma("unroll") for (int m = 0; m < 4; ++m) _Pragma("unroll") for (int n = 0; n < 2; ++n) _Pragma("unroll") for (int k = 0; k < 2; ++k) \
        acc[ai][bj][m][n] = __builtin_amdgcn_mfma_f32_16x16x32_bf16(Bt[n][k], At[m][k], acc[ai][bj][m][n], 0, 0, 0); __builtin_amdgcn_s_setprio(0); } while (0)
#define PG8_WAIT_V(n) asm volatile("s_waitcnt vmcnt(" #n ")" ::: "memory")
#define PG8_WAIT_L(n) asm volatile("s_waitcnt lgkmcnt(" #n ")" ::: "memory")
#define PG8_BAR __builtin_amdgcn_s_barrier()
#define PG8_SCHED __builtin_amdgcn_sched_barrier(0)
    Unit cur, nxt; int ui = 0;
    if (!S.next(0, cur)) return;
    f32x4 acc[2][2][4][2];
#pragma unroll
    for (int a = 0; a < 2; ++a)
#pragma unroll
        for (int b = 0; b < 2; ++b)
#pragma unroll
            for (int m = 0; m < 4; ++m)
#pragma unroll
                for (int n = 0; n < 2; ++n) acc[a][b][m][n] = (f32x4){0.f, 0.f, 0.f, 0.f};
    bf16x8 At[4][2], B0[2][2], B1[2][2];
    const char* cA = (const char*)g.A + (size_t)cur.pm * tstepA + (size_t)(cur.pn / g.adiv) * g.a_step; const char* cB = (const char*)g.Bt + (size_t)(cur.pn % g.bmod) * tstepB + (size_t)(cur.pn / g.adiv) * g.b_step;
    S.a_ready(cur);
    if constexpr (SP2) {
        PG8_STAGE(PG8_SB(0, 0), cB, voffB); PG8_STAGE(PG8_SB(0, 1), cB + hstepB, voffB); PG8_STAGE(PG8_SA(0, 0), cA, voffA); PG8_STAGE(PG8_SA(0, 1), cA + hstepA, voffA);
        if (wr == 1) PG8_BAR;
        PG8_WAIT_V(2); PG8_BAR;
        PG8_STAGE(PG8_SB(1, 0), cB + kstep, voffB); PG8_STAGE(PG8_SA(1, 0), cA + kstep, voffA); PG8_STAGE(PG8_SB(1, 1), cB + hstepB + kstep, voffB);
        PG8_WAIT_V(6); PG8_BAR;
    } else {
        PG8_STAGE(PG8_SB(0, 0), cB, voffB); PG8_STAGE(PG8_SA(0, 0), cA, voffA); PG8_STAGE(PG8_SB(0, 1), cB + hstepB, voffB); PG8_STAGE(PG8_SA(0, 1), cA + hstepA, voffA);
        if (wr == 1) PG8_BAR;
        PG8_WAIT_V(4); PG8_BAR;
        PG8_STAGE(PG8_SB(1, 0), cB + kstep, voffB); PG8_STAGE(PG8_SA(1, 0), cA + kstep, voffA); PG8_STAGE(PG8_SB(1, 1), cB + hstepB + kstep, voffB);
        PG8_WAIT_V(6); PG8_BAR;
    }
    for (;;) {
        const bool has_next = S.next(ui + 1, nxt);
        const char* nA = has_next ? (const char*)g.A + (size_t)nxt.pm * tstepA + (size_t)(nxt.pn / g.adiv) * g.a_step : cA; const char* nB = has_next ? (const char*)g.Bt + (size_t)(nxt.pn % g.bmod) * tstepB + (size_t)(nxt.pn / g.adiv) * g.b_step : cB;
        for (int t = 0; t < nt; t += 2) {
            const bool last = (t == nt - 2);
            const char* a1 = cA + (size_t)(t + 1) * kstep;
            const char* a2 = last ? nA : cA + (size_t)(t + 2) * kstep; const char* b2 = last ? nB : cB + (size_t)(t + 2) * kstep;
            const char* a3 = a2 + kstep; const char* b3 = b2 + kstep;
            if (last && has_next) S.a_ready(nxt);
            if constexpr (SP2) {
            PG8_LDB(B0, 0, 0); PG8_LDB(B1, 0, 1); PG8_SCHED; PG8_LDA(At, 0, 0); PG8_STAGE(PG8_SA(1, 1), a1 + hstepA, voffA);
            PG8_WAIT_V(8); PG8_WAIT_L(0); PG8_BAR; PG8_MMA(0, 0, At, B0); PG8_MMA(0, 1, At, B1); PG8_BAR; PG8_SCHED;
            PG8_LDA(At, 0, 1); PG8_STAGE(PG8_SB(0, 0), b2, voffB); PG8_STAGE(PG8_SB(0, 1), b2 + hstepB, voffB); PG8_STAGE(PG8_SA(0, 0), a2, voffA);
            PG8_WAIT_V(8); PG8_WAIT_L(0); PG8_BAR; PG8_MMA(1, 0, At, B0); PG8_MMA(1, 1, At, B1); PG8_BAR; PG8_SCHED;
            PG8_LDB(B0, 1, 0); PG8_LDB(B1, 1, 1); PG8_SCHED; PG8_LDA(At, 1, 0); PG8_STAGE(PG8_SA(0, 1), a2 + hstepA, voffA);
            PG8_WAIT_V(8); PG8_WAIT_L(0); PG8_BAR; PG8_MMA(0, 0, At, B0); PG8_MMA(0, 1, At, B1); PG8_BAR; PG8_SCHED;
            PG8_LDA(At, 1, 1); PG8_STAGE(PG8_SB(1, 0), b3, voffB); PG8_STAGE(PG8_SB(1, 1), b3 + hstepB, voffB); PG8_STAGE(PG8_SA(1, 0), a3, voffA);
            PG8_WAIT_V(8); PG8_WAIT_L(0); PG8_BAR; PG8_MMA(1, 0, At, B0); PG8_MMA(1, 1, At, B1); PG8_BAR; PG8_SCHED;
            } else {
            PG8_LDB(B0, 0, 0); PG8_SCHED; PG8_LDA(At, 0, 0); PG8_STAGE(PG8_SA(1, 1), a1 + hstepA, voffA);
            PG8_WAIT_L(8); PG8_BAR; PG8_WAIT_L(0); PG8_MMA(0, 0, At, B0); PG8_BAR; PG8_SCHED;
            PG8_LDB(B1, 0, 1); PG8_STAGE(PG8_SB(0, 0), b2, voffB);
            PG8_BAR; PG8_WAIT_L(0); PG8_MMA(0, 1, At, B1); PG8_BAR;
            PG8_LDA(At, 0, 1); PG8_STAGE(PG8_SA(0, 0), a2, voffA);
            PG8_BAR; PG8_WAIT_L(0); PG8_MMA(1, 0, At, B0); PG8_BAR; PG8_SCHED;
            PG8_STAGE(PG8_SB(0, 1), b2 + hstepB, voffB);
            PG8_WAIT_V(6); PG8_BAR; PG8_MMA(1, 1, At, B1); PG8_BAR;
            PG8_LDB(B0, 1, 0); PG8_SCHED; PG8_LDA(At, 1, 0); PG8_STAGE(PG8_SA(0, 1), a2 + hstepA, voffA);
            PG8_WAIT_L(8); PG8_BAR; PG8_WAIT_L(0); PG8_MMA(0, 0, At, B0); PG8_BAR; PG8_SCHED;
            PG8_LDB(B1, 1, 1); PG8_STAGE(PG8_SB(1, 0), b3, voffB);
            PG8_BAR; PG8_WAIT_L(0); PG8_MMA(0, 1, At, B1); PG8_BAR;
            PG8_LDA(At, 1, 1); PG8_STAGE(PG8_SA(1, 0), a3, voffA);
            PG8_BAR; PG8_WAIT_L(0); PG8_MMA(1, 0, At, B0); PG8_BAR; PG8_SCHED;
            PG8_STAGE(PG8_SB(1, 1), b3 + hstepB, voffB);
            PG8_WAIT_V(6); PG8_BAR; PG8_MMA(1, 1, At, B1); PG8_BAR;
            }
        }
        if constexpr (ALIGN_EPI) { if (wr == 0) PG8_BAR; }
        if constexpr (!Epi::AFTER_DRAIN) { E(acc, cur, wr, wc, fr, fq); S.done(cur); }
        if (!has_next) break;
#pragma unroll
        for (int a = 0; a < 2; ++a)
#pragma unroll
            for (int b = 0; b < 2; ++b)
#pragma unroll
                for (int m = 0; m < 4; ++m)
#pragma unroll
                    for (int n = 0; n < 2; ++n) acc[a][b][m][n] = (f32x4){0.f, 0.f, 0.f, 0.f};
        cur = nxt; cA = nA; cB = nB; ++ui;
        if constexpr (ALIGN_EPI) { if (wr == 1) PG8_BAR; }
    }
    PG8_WAIT_V(0);
    if constexpr (!ALIGN_EPI) { if (wr == 0) PG8_BAR; }
    PG8_BAR;
    if constexpr (Epi::AFTER_DRAIN) { E.fused(acc, cur, wr, wc, fr, fq, lds, wid, lane); S.done(cur); }
#undef PG8_SA
#undef PG8_SB
#undef PG8_STAGE
#undef PG8_LDA
#undef PG8_LDB
#undef PG8_MMA
#undef PG8_WAIT_V
#undef PG8_WAIT_L
#undef PG8_BAR
#undef PG8_SCHED
}
}
namespace att {
using bf16 = __hip_bfloat16;
constexpr int   D = 128, NW = 8, QBLK = 32, KVBLK = 64;
constexpr float SCALE = 0.088388347648318440f;
constexpr float THR = 8.f;
constexpr int SDEPTH = 1;
constexpr int LDQ = 1024, LDK = 256, LDO = 1024;
constexpr size_t SHM_V = KVBLK * D * 2, SHM_K = KVBLK * D * 2, SHM_ATTN = 2 * SHM_V + 2 * SHM_K + NW * 64 * 4;
using bf16x8 = __attribute__((ext_vector_type(8))) short;
using s16x4  = __attribute__((ext_vector_type(4))) short;
using f32x16 = __attribute__((ext_vector_type(16))) float;
using f32x8  = __attribute__((ext_vector_type(8))) float;
using u32x4  = __attribute__((ext_vector_type(4))) unsigned;
#define KSWZ(row, colB) ((row) * 256 + ((colB) ^ (((row) & 7) << 4)))
#define SBAR() __builtin_amdgcn_sched_barrier(0)
__device__ __forceinline__ int crow(int r, int hi) { return (r & 3) + 8 * (r >> 2) + 4 * hi; }
__device__ __forceinline__ unsigned cvtpk(float lo, float hi) {
  unsigned r; asm volatile("v_cvt_pk_bf16_f32 %0, %1, %2" : "=v"(r) : "v"(lo), "v"(hi)); return r;
}
template <typename TIn> struct Stage;
template <> struct Stage<bf16>  { using T = bf16x8;
  __device__ static __forceinline__ T ld8(const bf16* p) { return *reinterpret_cast<const bf16x8*>(p); }
  __device__ static __forceinline__ bf16x8 tobf(T x) { return x; } };
template <> struct Stage<float> { using T = f32x8;
  __device__ static __forceinline__ T ld8(const float* p) { return *reinterpret_cast<const f32x8*>(p); }
  __device__ static __forceinline__ bf16x8 tobf(T x) {
    u32x4 w = {cvtpk(x[0], x[1]), cvtpk(x[2], x[3]), cvtpk(x[4], x[5]), cvtpk(x[6], x[7])}; return *reinterpret_cast<bf16x8*>(&w); } };

__device__ __forceinline__ void partialSM(f32x16& p0, f32x16& p1, float mC) {
  (void)mC; (void)p1;
  for (int r = 0; r < 16; ++r) p0[r] = __builtin_amdgcn_exp2f(p0[r]);
}
__device__ __forceinline__ void finishSM(f32x16& p0, f32x16& p1, float& l_reg, bf16x8& pa0, bf16x8& pa1, bf16x8& pa2, bf16x8& pa3) {
  for (int r = 0; r < 16; ++r) p1[r] = __builtin_amdgcn_exp2f(p1[r]);
  float ps = 0; for (int r = 0; r < 16; ++r) ps += p0[r]; for (int r = 0; r < 16; ++r) ps += p1[r];
  { auto rr = __builtin_amdgcn_permlane32_swap(__float_as_uint(ps), __float_as_uint(ps), false, false);
    ps = __uint_as_float(rr[0]) + __uint_as_float(rr[1]); }
  l_reg += ps;
#define PK4(P, BASE, OUT) do { unsigned a0 = cvtpk(P[BASE + 0], P[BASE + 1]), a1 = cvtpk(P[BASE + 2], P[BASE + 3]);   \
    unsigned b0 = cvtpk(P[BASE + 4], P[BASE + 5]), b1 = cvtpk(P[BASE + 6], P[BASE + 7]);                              \
    auto r0 = __builtin_amdgcn_permlane32_swap(a0, b0, false, false); auto r1 = __builtin_amdgcn_permlane32_swap(a1, b1, false, false); \
    u32x4 w = {r0[0], r1[0], r0[1], r1[1]}; OUT = *reinterpret_cast<bf16x8*>(&w); } while (0)
  PK4(p0, 0, pa0); PK4(p0, 8, pa1); PK4(p1, 0, pa2); PK4(p1, 8, pa3);
#undef PK4
}
__device__ __forceinline__ void qkt(f32x16& p0, f32x16& p1, const bf16* Ks, const bf16x8* qr, int r32, int hi, const f32x16& negm) {
#pragma unroll
  for (int d0 = 0; d0 < 8; ++d0) { int cb = (d0 * 16 + hi * 8) * 2;
    bf16x8 b0 = *reinterpret_cast<const bf16x8*>((const char*)Ks + KSWZ(r32, cb));
    bf16x8 b1 = *reinterpret_cast<const bf16x8*>((const char*)Ks + KSWZ(32 + r32, cb));
    if (d0 == 0) { p0 = __builtin_amdgcn_mfma_f32_32x32x16_bf16(b0, qr[0], negm, 0, 0, 0); p1 = __builtin_amdgcn_mfma_f32_32x32x16_bf16(b1, qr[0], negm, 0, 0, 0); }
    else { p0 = __builtin_amdgcn_mfma_f32_32x32x16_bf16(b0, qr[d0], p0, 0, 0, 0); p1 = __builtin_amdgcn_mfma_f32_32x32x16_bf16(b1, qr[d0], p1, 0, 0, 0); } }
}
__device__ __forceinline__ int v_st(int k, int c) { const int kk = (k & ~0xC) | ((k & 4) << 1) | ((k & 8) >> 1); return ((kk >> 3) * 4 + (c >> 5)) * 512 + ((kk & 7) * 32 + (c & 31)) * 2; }
__device__ __forceinline__ int v_rd_base(int lane) { return ((lane & 3) << 3) | (((lane >> 2) & 3) << 6) | (((lane >> 4) & 1) << 5) | (((lane >> 5) & 1) << 8); }
constexpr int v_rd_off(int d0, int ks, int half) { return d0 * 512 + ks * 4096 + half * 2048; }
template <int OFF> __device__ __forceinline__ s16x4 tr_read(int vb) {
  s16x4 r; asm volatile("ds_read_b64_tr_b16 %0, %1 offset:%2" : "=&v"(r) : "v"(vb), "i"(OFF) : "memory"); return r;
}
template <int D0> __device__ __forceinline__ void pv_one(f32x16& od, int vb, bf16x8 pa0, bf16x8 pa1, bf16x8 pa2, bf16x8 pa3) {
  const s16x4 l0 = tr_read<v_rd_off(D0, 0, 0)>(vb), h0 = tr_read<v_rd_off(D0, 0, 1)>(vb), l1 = tr_read<v_rd_off(D0, 1, 0)>(vb), h1 = tr_read<v_rd_off(D0, 1, 1)>(vb);
  const s16x4 l2 = tr_read<v_rd_off(D0, 2, 0)>(vb), h2 = tr_read<v_rd_off(D0, 2, 1)>(vb), l3 = tr_read<v_rd_off(D0, 3, 0)>(vb), h3 = tr_read<v_rd_off(D0, 3, 1)>(vb);
  asm volatile("s_waitcnt lgkmcnt(0)" ::: "memory"); SBAR();
#define PK(L, H) (bf16x8){L[0], L[1], L[2], L[3], H[0], H[1], H[2], H[3]}
  od = __builtin_amdgcn_mfma_f32_32x32x16_bf16(pa0, PK(l0, h0), od, 0, 0, 0);
  od = __builtin_amdgcn_mfma_f32_32x32x16_bf16(pa1, PK(l1, h1), od, 0, 0, 0);
  od = __builtin_amdgcn_mfma_f32_32x32x16_bf16(pa2, PK(l2, h2), od, 0, 0, 0);
  od = __builtin_amdgcn_mfma_f32_32x32x16_bf16(pa3, PK(l3, h3), od, 0, 0, 0);
#undef PK
}
__device__ __forceinline__ void pv_d0(f32x16* o, int vb, bf16x8 pa0, bf16x8 pa1, bf16x8 pa2, bf16x8 pa3) {
  pv_one<0>(o[0], vb, pa0, pa1, pa2, pa3); pv_one<1>(o[1], vb, pa0, pa1, pa2, pa3); pv_one<2>(o[2], vb, pa0, pa1, pa2, pa3); pv_one<3>(o[3], vb, pa0, pa1, pa2, pa3);
}

template <typename TQ>
__device__ __forceinline__ void attn_dense_body(const TQ* __restrict__ Qb, const bf16* __restrict__ Kh, const bf16* __restrict__ Vh,
                                                bf16* __restrict__ Ob, int seq, char* lds, float mC, const float* __restrict__ gq, const float* __restrict__ rc, const float* __restrict__ rsn, int trow0) {
  using St = Stage<bf16>; using SQ = Stage<TQ>;
  int tid_ = threadIdx.x; asm volatile("" : "+v"(tid_));
  const int tid = tid_, wid = __builtin_amdgcn_readfirstlane(tid >> 6), lane = tid & 63, r32 = lane & 31, hi = lane >> 5;
  bf16* V_lds = (bf16*)lds; bf16* K_lds = (bf16*)(lds + 2 * SHM_V);
  float* ws = (float*)(lds + 2 * SHM_V + 2 * SHM_K) + wid * 64; float* li_l = ws;
  float l_reg = 0; f32x16 o[4] = {}; bf16x8 qr[8];
  const TQ* Qw = Qb + (long)(wid * QBLK + r32) * LDQ + hi * 8;
#pragma unroll
  for (int d0 = 0; d0 < 8; ++d0) qr[d0] = SQ::tobf(SQ::ld8(Qw + d0 * 16));
  const int sr = tid >> 4, sc = (tid & 15) * 8, vst0 = v_st(sr, sc), vst1 = v_st(32 + sr, sc);
  const int vb0 = (int)(uintptr_t)V_lds + v_rd_base(lane);
  struct { typename St::T vs0, vs1, ks0, ks1; } sr_[SDEPTH];
#define SLOAD(i, k0) do { sr_[i].vs0 = St::ld8(&Vh[(long)((k0) + sr) * LDK + sc]); sr_[i].vs1 = St::ld8(&Vh[(long)((k0) + 32 + sr) * LDK + sc]); \
    sr_[i].ks0 = St::ld8(&Kh[(long)((k0) + sr) * LDK + sc]); sr_[i].ks1 = St::ld8(&Kh[(long)((k0) + 32 + sr) * LDK + sc]); } while (0)
#define SWRITE(b, i) do { *(bf16x8*)((char*)V_lds + (b) * SHM_V + vst0) = St::tobf(sr_[i].vs0);          \
    *(bf16x8*)((char*)V_lds + (b) * SHM_V + vst1) = St::tobf(sr_[i].vs1); int kc = sc * 2;               \
    *(bf16x8*)((char*)K_lds + (b) * SHM_K + KSWZ(sr, kc)) = St::tobf(sr_[i].ks0);                       \
    *(bf16x8*)((char*)K_lds + (b) * SHM_K + KSWZ(32 + sr, kc)) = St::tobf(sr_[i].ks1); } while (0)
#define SWAIT() do { if constexpr (SDEPTH == 2) asm volatile("s_waitcnt vmcnt(4)" ::: "memory"); else asm volatile("s_waitcnt vmcnt(0)" ::: "memory"); } while (0)
  constexpr int SE = 0, SO = SDEPTH - 1;
  SLOAD(SE, 0);
  {
    float ss = 0.f;
#define QF(d, e) __uint_as_float(((unsigned)(unsigned short)qr[d][e]) << 16)
#pragma unroll
    for (int d0 = 0; d0 < 8; ++d0)
#pragma unroll
      for (int e = 0; e < 8; ++e) { const float x = QF(d0, e); ss += x * x; }
    ss += __shfl_xor(ss, 32);
    const float rn = (SCALE * 1.4426950408889634f) / sqrtf(ss * (1.0f / 128.0f) + 1e-6f);
    const int t = trow0 + wid * QBLK + r32; const int prow = t >> 6, pcol = t & 63;
#pragma unroll
    for (int hf = 0; hf < 2; ++hf)
#pragma unroll
      for (int dd = 0; dd < 2; ++dd) {
        const int dl = 4 * hf + dd, du = dl + 2;
        const int f0 = 16 * dd + 8 * hi;
        const float* cp = rc + (hf ? pcol : prow) * 32 + f0; const float* sp = rsn + (hf ? pcol : prow) * 32 + f0;
        const float* gl = gq + 16 * dl + 8 * hi; const float* gu = gq + 16 * du + 8 * hi;
        unsigned wl[4], wu[4];
#pragma unroll
        for (int e = 0; e < 8; e += 2) {
          float o1[2], o2[2];
#pragma unroll
          for (int k = 0; k < 2; ++k) { const float x1 = QF(dl, e + k) * rn * gl[e + k], x2 = QF(du, e + k) * rn * gu[e + k]; const float c = cp[e + k], sn = sp[e + k];
            o1[k] = x1 * c - x2 * sn; o2[k] = x2 * c + x1 * sn; }
          wl[e >> 1] = cvtpk(o1[0], o1[1]); wu[e >> 1] = cvtpk(o2[0], o2[1]);
        }
        u32x4 vl = {wl[0], wl[1], wl[2], wl[3]}, vu = {wu[0], wu[1], wu[2], wu[3]};
        qr[dl] = *reinterpret_cast<bf16x8*>(&vl); qr[du] = *reinterpret_cast<bf16x8*>(&vu);
      }
  }
#undef QF
  SBAR();
  f32x16 pA0, pA1, pB0, pB1; bf16x8 pa0, pa1, pa2, pa3; const int NT = seq / KVBLK;
  f32x16 negm;
#pragma unroll
  for (int r = 0; r < 16; ++r) negm[r] = -mC;
  asm volatile("" : "+v"(negm));
  asm volatile("s_waitcnt vmcnt(0)" ::: "memory"); SWRITE(0, SE); __syncthreads();
  qkt(pA0, pA1, K_lds, qr, r32, hi, negm); partialSM(pA0, pA1, mC);
  SLOAD(SO, KVBLK); if constexpr (SDEPTH == 2) { if (2 < NT) SLOAD(SE, 2 * KVBLK); }
  SWAIT(); SWRITE(1, SO); __syncthreads();
  for (int j = 1; j + 1 < NT; j += 2) {
    SBAR(); SLOAD(SO, (j + SDEPTH) * KVBLK); SBAR();
    qkt(pB0, pB1, (bf16*)((char*)K_lds + SHM_K), qr, r32, hi, negm);
    finishSM(pA0, pA1, l_reg, pa0, pa1, pa2, pa3); SBAR();
    pv_d0(o, vb0, pa0, pa1, pa2, pa3); partialSM(pB0, pB1, mC);
    __syncthreads(); SWAIT(); SWRITE(0, SE);
    __syncthreads();
    SBAR(); if (SDEPTH == 1 || j + 3 < NT) SLOAD(SE, (j + 1 + SDEPTH) * KVBLK); SBAR();
    qkt(pA0, pA1, K_lds, qr, r32, hi, negm);
    finishSM(pB0, pB1, l_reg, pa0, pa1, pa2, pa3); SBAR();
    pv_d0(o, vb0 + (int)SHM_V, pa0, pa1, pa2, pa3); partialSM(pA0, pA1, mC);
    __syncthreads(); SWAIT(); SWRITE(1, SO);
    __syncthreads();
  }
  SBAR(); qkt(pB0, pB1, (bf16*)((char*)K_lds + SHM_K), qr, r32, hi, negm);
  finishSM(pA0, pA1, l_reg, pa0, pa1, pa2, pa3); SBAR();
  pv_d0(o, vb0, pa0, pa1, pa2, pa3); partialSM(pB0, pB1, mC);
  __syncthreads();
  finishSM(pB0, pB1, l_reg, pa0, pa1, pa2, pa3); SBAR();
  pv_d0(o, vb0 + (int)SHM_V, pa0, pa1, pa2, pa3);
  if (hi == 0) li_l[r32] = l_reg; asm volatile("s_waitcnt lgkmcnt(0)" ::: "memory");
  float rli[16];
#pragma unroll
  for (int r = 0; r < 16; ++r) rli[r] = __builtin_amdgcn_rcpf(li_l[crow(r, hi)]);
  int le = (int)(threadIdx.x & 63u); asm volatile("" : "+v"(le));
  const int r32e = le & 31, hie = le >> 5;
  bf16* Ow = Ob + (long)(wid * QBLK) * LDO;
#pragma unroll
  for (int r = 0; r < 16; ++r) { int orow = crow(r, hie);
    for (int d0 = 0; d0 < 4; ++d0) Ow[(long)orow * LDO + d0 * 32 + r32e] = __float2bfloat16(o[d0][r] * rli[r]); }
#undef SLOAD
#undef SWRITE
#undef SWAIT
}
}
constexpr int DM = 1024, NBATCH = 2, SEQ = 8192, CTXL = 256, MLAT = NBATCH * SEQ, MCTX = NBATCH * CTXL, MALL = MLAT + MCTX;
constexpr int FF = 4096, NQKV = 1536, SKV = SEQ + CTXL, MODW = 6 * DM;
constexpr float EPS = 1e-6f;
constexpr int NWAVES = 8, NTHR = 512;
constexpr size_t MiB = 1u << 20;
constexpr size_t WS_CTL = 0;
constexpr size_t WS_MODS = 1 * MiB;
constexpr size_t WS_RSTD = 1 * MiB + 256 * 1024;
constexpr size_t WS_ROPE = 1 * MiB + 512 * 1024;
constexpr size_t WS_XCTX = 2 * MiB;
constexpr size_t WS_WPOOL = 4 * MiB, WS_WQKV = 5 * MiB, WS_WO = 8 * MiB, WS_WIN0 = 10 * MiB, WS_WIN1 = 18 * MiB, WS_WOUT0 = 26 * MiB, WS_WOUT1 = 34 * MiB;
constexpr size_t WS_AY = 42 * MiB;
constexpr size_t WS_H = 76 * MiB;
constexpr size_t WS_DIFF = WS_H, WS_Q = WS_H, WS_K = 110 * MiB, WS_V = 119 * MiB, WS_O = 128 * MiB;
constexpr size_t WS_XB = 208 * MiB;
constexpr int KSPLIT = 8;
constexpr size_t WS_END = 242 * MiB;
static_assert(WS_AY + (size_t)MALL * DM * 2 <= WS_H && WS_H + (size_t)MALL * FF * 2 <= WS_XB && WS_XB + (size_t)MALL * DM * 2 <= WS_END && (size_t)KSPLIT * MCTX * DM <= (size_t)MLAT * DM, "ws map");
static_assert(WS_Q + (size_t)MALL * DM * 2 <= WS_K && WS_K + (size_t)NBATCH * SKV * 256 * 2 <= WS_V && WS_V + (size_t)NBATCH * SKV * 256 * 2 <= WS_O, "ws map 2");

constexpr int RING_BYTES = 131072, LDS_BYTES = 147456;

#define LAS __attribute__((address_space(3)))
typedef unsigned short bf16r;
typedef float f32x4 __attribute__((ext_vector_type(4)));
typedef unsigned u32x2 __attribute__((ext_vector_type(2)));
typedef unsigned u32x4 __attribute__((ext_vector_type(4)));

__device__ __forceinline__ unsigned f2bf(float f) { unsigned u = __builtin_bit_cast(unsigned, f); return (u + 0x7fffu + ((u >> 16) & 1u)) >> 16; }
__device__ __forceinline__ unsigned pk2(float lo, float hi) {
    typedef float f32x2_c __attribute__((ext_vector_type(2))); typedef __bf16 bf16x2_c __attribute__((ext_vector_type(2)));
    const f32x2_c v = {lo, hi}; return __builtin_bit_cast(unsigned, __builtin_convertvector(v, bf16x2_c)); }
__device__ __forceinline__ float bflo(unsigned w) { return __uint_as_float(w << 16); }
__device__ __forceinline__ float bfhi(unsigned w) { return __uint_as_float(w & 0xffff0000u); }
__device__ __forceinline__ float wave_sum(float v) {
#pragma unroll
    for (int o = 1; o < 64; o <<= 1) v += __shfl_xor(v, o);
    return v;
}

struct KArgs {
    const float *x, *c, *ctx, *c_ctx, *w_ada, *b_ada, *g_mix_pre, *g_mix_post, *g_mlp_pre, *g_mlp_post, *w_pool, *pool_scale, *w_qkv, *g_q, *g_k, *w_o, *w_mlp_in, *w_mlp_out;
    float* out; unsigned char* ws; int ph_lo, ph_hi;
};

__device__ __forceinline__ void p0_transpose_item(const float* W, int K, int N, bf16r* WT, int row_off, LAS float* scr, int item, int lane, const float* colscale = nullptr) {
    const int nblk = N / 32, kb = item / nblk, nb = item % nblk, k0 = 64 * kb, n0 = 32 * nb;
    const int kr = lane >> 3, nq = lane & 7;
    f32x4 v[8];
#pragma unroll
    for (int i = 0; i < 8; ++i) v[i] = __builtin_nontemporal_load((const f32x4*)(W + (size_t)(k0 + 8 * i + kr) * N + n0 + 4 * nq));
#pragma unroll
    for (int i = 0; i < 8; ++i) { LAS float* d = scr + (8 * i + kr) * 33 + 4 * nq; d[0] = v[i].x; d[1] = v[i].y; d[2] = v[i].z; d[3] = v[i].w; }
    asm volatile("s_waitcnt lgkmcnt(0)" ::: "memory");
    const int c = lane & 7;
#pragma unroll
    for (int j = 0; j < 4; ++j) { const int n = (lane >> 3) + 8 * j; const LAS float* sp = scr + (8 * c) * 33 + n;
        const float sc = colscale ? colscale[row_off + n0 + n] : 1.0f;
        u32x4 o; o.x = pk2(sp[0 * 33] * sc, sp[1 * 33] * sc); o.y = pk2(sp[2 * 33] * sc, sp[3 * 33] * sc); o.z = pk2(sp[4 * 33] * sc, sp[5 * 33] * sc); o.w = pk2(sp[6 * 33] * sc, sp[7 * 33] * sc);
        *(u32x4*)(WT + (size_t)(row_off + n0 + n) * K + k0 + 8 * c) = o; }
    asm volatile("s_waitcnt lgkmcnt(0)" ::: "memory");
}

__device__ __forceinline__ void convert_weights(const KArgs& a, LAS unsigned char* lds, int wave, int lane, int gw, int NGW, bool late) {
    unsigned char* ws = a.ws;
    LAS float* scr = (LAS float*)(lds + wave * 16384);
    constexpr int I_POOL = (256 / 64) * (256 / 32), I_QKV = (DM / 64) * (NQKV / 32), I_O = (DM / 64) * (DM / 32), I_IN = (DM / 64) * (FF / 32), I_OUT = (FF / 64) * (DM / 32);
    if (!late) {
        for (int it = gw; it < 4 * I_POOL + I_IN + I_OUT; it += NGW) {
            int r = it;
            if (r < 4 * I_POOL) { const int g = r / I_POOL; p0_transpose_item(a.w_pool + (size_t)g * 65536, 256, 256, (bf16r*)(ws + WS_WPOOL), g * 256, scr, r % I_POOL, lane, a.pool_scale); continue; } r -= 4 * I_POOL;
            if (r < I_IN) { p0_transpose_item(a.w_mlp_in, DM, FF, (bf16r*)(ws + WS_WIN0), 0, scr, r, lane); continue; } r -= I_IN;
            p0_transpose_item(a.w_mlp_out, FF, DM, (bf16r*)(ws + WS_WOUT0), 0, scr, r, lane);
        }
    } else {
        for (int it = gw; it < I_QKV + I_O + I_IN + I_OUT; it += NGW) {
            int r = it;
            if (r < I_QKV) { p0_transpose_item(a.w_qkv, DM, NQKV, (bf16r*)(ws + WS_WQKV), 0, scr, r, lane); continue; } r -= I_QKV;
            if (r < I_O) { p0_transpose_item(a.w_o, DM, DM, (bf16r*)(ws + WS_WO), 0, scr, r, lane); continue; } r -= I_O;
            if (r < I_IN) { p0_transpose_item(a.w_mlp_in + (size_t)DM * FF, DM, FF, (bf16r*)(ws + WS_WIN1), 0, scr, r, lane); continue; } r -= I_IN;
            p0_transpose_item(a.w_mlp_out + (size_t)DM * FF, FF, DM, (bf16r*)(ws + WS_WOUT1), 0, scr, r, lane);
        }
    }
}

__device__ __forceinline__ void phase0(const KArgs& a, LAS unsigned char* lds, int tid, int lane, int wave) {
    unsigned char* ws = a.ws;
    float* mods = (float*)(ws + WS_MODS);
    for (int it = blockIdx.x; it < 96; it += gridDim.x) {
        const int layer = it / 48, nb = (it % 48) >> 1, kh = it & 1;
        LAS float* sil = (LAS float*)lds; LAS float* part = sil + 3072;
        for (int i = tid; i < 3072; i += NTHR) { const int s = i >> 10, k = i & 1023; const float v = s < 2 ? a.c[s * 1024 + k] : a.c_ctx[k]; sil[i] = v / (1.f + __expf(-v)); }
        __syncthreads();
        const float* W = a.w_ada + (size_t)layer * DM * MODW + nb * 256 + 4 * lane;
        f32x4 a0 = {0, 0, 0, 0}, a1 = {0, 0, 0, 0}, a2 = {0, 0, 0, 0};
        const int kbase = kh * 512 + wave * 64;
        for (int kb = 0; kb < 64; kb += 32) {
            f32x4 wv[32];
#pragma unroll
            for (int i = 0; i < 32; ++i) wv[i] = __builtin_nontemporal_load((const f32x4*)(W + (size_t)(kbase + kb + i) * MODW));
#pragma unroll
            for (int i = 0; i < 32; ++i) { const int k = kbase + kb + i; a0 += sil[k] * wv[i]; a1 += sil[1024 + k] * wv[i]; a2 += sil[2048 + k] * wv[i]; }
        }
#pragma unroll
        for (int e = 0; e < 4; ++e) { part[(wave * 3 + 0) * 256 + 4 * lane + e] = a0[e]; part[(wave * 3 + 1) * 256 + 4 * lane + e] = a1[e]; part[(wave * 3 + 2) * 256 + 4 * lane + e] = a2[e]; }
        __syncthreads();
        for (int i = tid; i < 768; i += NTHR) { const int s = i >> 8, n = i & 255; float sum = 0.f;
#pragma unroll
            for (int w = 0; w < 8; ++w) sum += part[(w * 3 + s) * 256 + n];
            if (kh == 0) sum += a.b_ada[layer * MODW + nb * 256 + n];
            atomicAdd(&mods[(layer * 3 + s) * MODW + nb * 256 + n], sum); }
        __syncthreads();
    }
    {
        LAS float* scr = (LAS float*)(lds + wave * 16384);
        const int gw = blockIdx.x * NWAVES + wave, NGW = gridDim.x * NWAVES;
        const bool many = gridDim.x > 192;
        if (!(many && blockIdx.x < 96)) convert_weights(a, lds, wave, lane, many ? ((int)blockIdx.x - 96) * NWAVES + wave : gw, many ? ((int)gridDim.x - 96) * NWAVES : NGW, false);
        float* rstd = (float*)(ws + WS_RSTD);
        for (int ch = gw; ch < MALL / 4; ch += NGW) {
            f32x4 v[4][4];
#pragma unroll
            for (int rr = 0; rr < 4; ++rr) { const int r = 4 * ch + rr; const float* xr = (r < MLAT ? a.x + (size_t)r * DM : a.ctx + (size_t)(r - MLAT) * DM) + 4 * lane;
#pragma unroll
                for (int j = 0; j < 4; ++j) v[rr][j] = __builtin_nontemporal_load((const f32x4*)(xr + 256 * j)); }
            float ss[4];
#pragma unroll
            for (int rr = 0; rr < 4; ++rr) { ss[rr] = 0.f;
#pragma unroll
                for (int j = 0; j < 4; ++j) ss[rr] += (v[rr][j].x * v[rr][j].x + v[rr][j].y * v[rr][j].y) + (v[rr][j].z * v[rr][j].z + v[rr][j].w * v[rr][j].w); }
#pragma unroll
            for (int o = 1; o < 64; o <<= 1) {
#pragma unroll
                for (int rr = 0; rr < 4; ++rr) ss[rr] += __shfl_xor(ss[rr], o); }
            if (lane < 4) { const float sv = lane == 0 ? ss[0] : lane == 1 ? ss[1] : lane == 2 ? ss[2] : ss[3]; rstd[4 * ch + lane] = 1.0f / sqrtf(sv * (1.0f / DM) + EPS); }
        }
    }
    {
        float* rc = (float*)(ws + WS_ROPE); float* rs = rc + 4096;
        for (int i = blockIdx.x * NTHR + tid; i < 4096; i += gridDim.x * NTHR) {
            const int p = i >> 5, f = i & 31;
            const float inv = (float)exp(-(double)f * (9.210340371976184 / 32.0));
            const float ang = (float)p * inv;
            const double ad = (double)ang, q = rint(ad * 0.6366197723675814);
            double r = fma(-q, 1.5707963267948966, ad); r = fma(-q, 6.123233995736766e-17, r);
            const double r2 = r * r;
            const double s = r * (1.0 + r2 * (-1.0 / 6 + r2 * (1.0 / 120 + r2 * (-1.0 / 5040 + r2 * (1.0 / 362880 + r2 * (-1.0 / 39916800 + r2 * (1.0 / 6227020800.0)))))));
            const double cc = 1.0 + r2 * (-0.5 + r2 * (1.0 / 24 + r2 * (-1.0 / 720 + r2 * (1.0 / 40320 + r2 * (-1.0 / 3628800 + r2 * (1.0 / 479001600.0 + r2 * (-1.0 / 87178291200.0)))))));
            const int qi = ((int)q) & 3;
            const double sn = qi == 0 ? s : qi == 1 ? cc : qi == 2 ? -s : -cc;
            const double cs = qi == 0 ? cc : qi == 1 ? -s : qi == 2 ? -cc : s;
            rc[i] = (float)cs; rs[i] = (float)sn;
        }
    }
}

template <int HW>
__device__ __forceinline__ void diff_run(const float* src, const float* rstd, int t0, int L, f32x4 gs, f32x4 sh, bf16r* dst, int lane) {
    constexpr int RUN = 16, NR = RUN + 2 * HW - 1;
    const int ti = t0 - HW + lane; const bool vi = (ti >= 0) && (ti < L) && (lane < NR);
    const float rl = vi ? rstd[ti] : 0.f;
    f32x4 h[NR];
#pragma unroll
    for (int i = 0; i < NR; ++i) { int tc = t0 - HW + i; tc = tc < 0 ? 0 : tc; tc = tc > L - 1 ? L - 1 : tc; h[i] = __builtin_nontemporal_load((const f32x4*)(src + (size_t)tc * DM)); }
#pragma unroll
    for (int i = 0; i < NR; ++i) { const float rs = __shfl(rl, i); h[i] = (h[i] * rs) * gs; }
    f32x4 S = {0.f, 0.f, 0.f, 0.f};
#pragma unroll
    for (int i = 0; i < 2 * HW - 1; ++i) S += h[i];
#pragma unroll
    for (int tt = 0; tt < RUN; ++tt) {
        S += h[tt + 2 * HW - 1];
        const int t = t0 + tt; const int lo = (t - HW) > 0 ? (t - HW) : 0, hi = (t + HW) < L ? (t + HW) : L;
        const float inv = 1.0f / (float)(hi - lo);
        const f32x4 d = (S * inv + sh) - (h[tt + HW] + sh);
        u32x2 o; o.x = pk2(d.x, d.y); o.y = pk2(d.z, d.w);
        *(u32x2*)(dst + (size_t)tt * DM) = o;
        S -= h[tt];
    }
}
__device__ __forceinline__ void phase_diff(const KArgs& a, int lane, int wave) {
    unsigned char* ws = a.ws;
    const float* mods = (const float*)(ws + WS_MODS);
    const float* rstd = (const float*)(ws + WS_RSTD);
    bf16r* diff = (bf16r*)(ws + WS_DIFF);
    const int gw = blockIdx.x * NWAVES + wave, NGW = gridDim.x * NWAVES;
    for (int it = gw; it < (MALL / 16) * 4; it += NGW) {
        const int g = it & 3, run = it >> 2, r0 = run * 16;
        const float* src; const float* rs; int t0, L, ms;
        if (r0 < MLAT) { const int b = r0 / SEQ; t0 = r0 % SEQ; L = SEQ; src = a.x + (size_t)b * SEQ * DM; rs = rstd + b * SEQ; ms = b; }
        else { const int rr = r0 - MLAT; const int b = rr / CTXL; t0 = rr % CTXL; L = CTXL; src = a.ctx + (size_t)b * CTXL * DM; rs = rstd + MLAT + b * CTXL; ms = 2; }
        const int col = g * 256 + 4 * lane;
        const f32x4 gpre = *(const f32x4*)(a.g_mix_pre + col);
        const f32x4 sh = *(const f32x4*)(mods + ms * MODW + 0 * DM + col);
        const f32x4 sc = *(const f32x4*)(mods + ms * MODW + 1 * DM + col);
        const f32x4 gs = gpre * (1.0f + sc);
        bf16r* dst = diff + (size_t)r0 * DM + col;
        src += col;
        if (g == 0) diff_run<1>(src, rs, t0, L, gs, sh, dst, lane);
        else if (g == 1) diff_run<2>(src, rs, t0, L, gs, sh, dst, lane);
        else if (g == 2) diff_run<4>(src, rs, t0, L, gs, sh, dst, lane);
        else diff_run<8>(src, rs, t0, L, gs, sh, dst, lane);
    }
}

template <bool FIRST, bool HAS_NEXT, bool CTXSPLIT = false>
__device__ __forceinline__ void phase_rows(const KArgs& a, int row_begin, int nrows, int CH, const float* mods_cur, int gate_ch, const float* g_post, const float* mods_nxt, int sh_ch, const float* g_pre, int lane, int wave) {
    unsigned char* ws = a.ws;
    bf16r* AY = (bf16r*)(ws + WS_AY); bf16r* XB = (bf16r*)(ws + WS_XB);
    const int gw = blockIdx.x * NWAVES + wave, NGW = gridDim.x * NWAVES;
#define RCOL(j) (512 * ((j) >> 1) + 8 * lane + 4 * ((j) & 1))
#define UNPK(V_, lo4, hi4) do { lo4 = (f32x4){bflo((V_).x), bfhi((V_).x), bflo((V_).y), bfhi((V_).y)}; hi4 = (f32x4){bflo((V_).z), bfhi((V_).z), bflo((V_).w), bfhi((V_).w)}; } while (0)
    for (int ch = gw; ch < nrows / CH; ch += NGW) {
        const int r0 = row_begin + ch * CH; const int ms = r0 < MLAT ? r0 / SEQ : 2;
        f32x4 gg[4], gs[4], sh[4];
#pragma unroll
        for (int j = 0; j < 4; ++j) { const int col = RCOL(j);
            gg[j] = *(const f32x4*)(mods_cur + ms * MODW + gate_ch * DM + col) * *(const f32x4*)(g_post + col);
            if (HAS_NEXT) { gs[j] = *(const f32x4*)(g_pre + col) * (1.0f + *(const f32x4*)(mods_nxt + ms * MODW + (sh_ch + 1) * DM + col)); sh[j] = *(const f32x4*)(mods_nxt + ms * MODW + sh_ch * DM + col); }
        }
        for (int rr = 0; rr < CH; rr += 2) {
            f32x4 xv[2][4], yv[2][4]; float ss[2], s2[2];
#pragma unroll
            for (int q = 0; q < 2; ++q) { const int r = r0 + rr + q;
                const float* xin = r < MLAT ? a.x + (size_t)r * DM : a.ctx + (size_t)(r - MLAT) * DM;
                const bf16r* ay = AY + (size_t)r * DM; ss[q] = 0.f;
#pragma unroll
                for (int jp = 0; jp < 2; ++jp) { const int c8 = 512 * jp + 8 * lane;
                    if (FIRST) { xv[q][2 * jp] = __builtin_nontemporal_load((const f32x4*)(xin + c8)); xv[q][2 * jp + 1] = __builtin_nontemporal_load((const f32x4*)(xin + c8 + 4)); }
                    else { const u32x4 xw = *(const u32x4*)(XB + (size_t)r * DM + c8); UNPK(xw, xv[q][2 * jp], xv[q][2 * jp + 1]); }
                    if (CTXSPLIT && r >= MLAT) {
#pragma unroll
                        for (int h = 0; h < 2; ++h) { const float* pp = (const float*)a.out + (size_t)(r - MLAT) * DM + c8 + 4 * h; f32x4 acc4 = *(const f32x4*)pp;
#pragma unroll
                            for (int ks = 1; ks < KSPLIT; ++ks) acc4 += *(const f32x4*)(pp + (size_t)ks * MCTX * DM);
                            yv[q][2 * jp + h] = acc4; } }
                    else { const u32x4 w = *(const u32x4*)(ay + c8); UNPK(w, yv[q][2 * jp], yv[q][2 * jp + 1]); } } }
#pragma unroll
            for (int q = 0; q < 2; ++q)
#pragma unroll
                for (int j = 0; j < 4; ++j) ss[q] += (yv[q][j].x * yv[q][j].x + yv[q][j].y * yv[q][j].y) + (yv[q][j].z * yv[q][j].z + yv[q][j].w * yv[q][j].w);
#pragma unroll
            for (int o = 1; o < 64; o <<= 1) { ss[0] += __shfl_xor(ss[0], o); ss[1] += __shfl_xor(ss[1], o); }
#pragma unroll
            for (int q = 0; q < 2; ++q) { const int r = r0 + rr + q;
                const float ry = 1.0f / sqrtf(ss[q] * (1.0f / DM) + EPS); s2[q] = 0.f;
#pragma unroll
                for (int j = 0; j < 4; ++j) { xv[q][j] = xv[q][j] + gg[j] * (yv[q][j] * ry);
                    s2[q] += (xv[q][j].x * xv[q][j].x + xv[q][j].y * xv[q][j].y) + (xv[q][j].z * xv[q][j].z + xv[q][j].w * xv[q][j].w); }
#pragma unroll
                for (int jp = 0; jp < 2; ++jp) { const int c8 = 512 * jp + 8 * lane; const f32x4 lo4 = xv[q][2 * jp], hi4 = xv[q][2 * jp + 1];
                    if (HAS_NEXT) { u32x4 xo; xo.x = pk2(lo4.x, lo4.y); xo.y = pk2(lo4.z, lo4.w); xo.z = pk2(hi4.x, hi4.y); xo.w = pk2(hi4.z, hi4.w); *(u32x4*)(XB + (size_t)r * DM + c8) = xo; }
                    else { *(f32x4*)(a.out + (size_t)r * DM + c8) = lo4; *(f32x4*)(a.out + (size_t)r * DM + c8 + 4) = hi4; } } }
            if (HAS_NEXT) {
#pragma unroll
                for (int o = 1; o < 64; o <<= 1) { s2[0] += __shfl_xor(s2[0], o); s2[1] += __shfl_xor(s2[1], o); }
#pragma unroll
                for (int q = 0; q < 2; ++q) { const int r = r0 + rr + q; bf16r* ay = AY + (size_t)r * DM;
                    const float rx = 1.0f / sqrtf(s2[q] * (1.0f / DM) + EPS);
#pragma unroll
                    for (int jp = 0; jp < 2; ++jp) { const int c8 = 512 * jp + 8 * lane;
                        const f32x4 a0 = (xv[q][2 * jp] * rx) * gs[2 * jp] + sh[2 * jp], a1 = (xv[q][2 * jp + 1] * rx) * gs[2 * jp + 1] + sh[2 * jp + 1];
                        u32x4 o; o.x = pk2(a0.x, a0.y); o.y = pk2(a0.z, a0.w); o.z = pk2(a1.x, a1.y); o.w = pk2(a1.z, a1.w); *(u32x4*)(ay + c8) = o; } }
            }
        }
    }
#undef RCOL
#undef UNPK
}

__device__ __forceinline__ void phase_qknorm(const KArgs& a, int lane, int wave) {
    unsigned char* ws = a.ws;
    bf16r* Q = (bf16r*)(ws + WS_Q); bf16r* Kb = (bf16r*)(ws + WS_K);
    const float* rc = (const float*)(ws + WS_ROPE); const float* rsn = rc + 4096;
    const int gw = blockIdx.x * NWAVES + wave, NGW = gridDim.x * NWAVES;
    const int i0 = 4 * (lane & 31);
    const int f0 = i0 & 31; const bool first_half = i0 < 64; const bool lower = (i0 & 32) == 0;
    const f32x4 gq = *(const f32x4*)(a.g_q + i0), gk = *(const f32x4*)(a.g_k + i0);
    for (int it = gw; it < NBATCH * SKV / 8; it += NGW) {
        u32x2 w[8]; f32x4 cs[8], sn[8];
#pragma unroll
        for (int q = 0; q < 8; ++q) { const int kr = 8 * it + q; const int key = kr % SKV; const bool rope = key >= CTXL; const int t = rope ? key - CTXL : 0; const int p = first_half ? (t >> 6) : (t & 63);
            cs[q] = *(const f32x4*)(rc + p * 32 + f0); sn[q] = *(const f32x4*)(rsn + p * 32 + f0);
            if (!rope) { cs[q] = (f32x4){1.f, 1.f, 1.f, 1.f}; sn[q] = (f32x4){0.f, 0.f, 0.f, 0.f}; }
            w[q] = *(const u32x2*)(Kb + (size_t)kr * 256 + 4 * lane); }
        f32x4 v[8]; float ss[8];
#pragma unroll
        for (int q = 0; q < 8; ++q) { v[q] = (f32x4){bflo(w[q].x), bfhi(w[q].x), bflo(w[q].y), bfhi(w[q].y)}; ss[q] = (v[q].x * v[q].x + v[q].y * v[q].y) + (v[q].z * v[q].z + v[q].w * v[q].w); }
#pragma unroll
        for (int o = 1; o < 32; o <<= 1)
#pragma unroll
            for (int q = 0; q < 8; ++q) ss[q] += __shfl_xor(ss[q], o);
#pragma unroll
        for (int q = 0; q < 8; ++q) { const float rn = 1.0f / sqrtf(ss[q] * (1.0f / 128.0f) + EPS);
            const f32x4 vn = (v[q] * rn) * gk;
            f32x4 pv; pv.x = __shfl_xor(vn.x, 8); pv.y = __shfl_xor(vn.y, 8); pv.z = __shfl_xor(vn.z, 8); pv.w = __shfl_xor(vn.w, 8);
            const f32x4 o4 = lower ? (vn * cs[q] - pv * sn[q]) : (vn * cs[q] + pv * sn[q]);
            u32x2 o; o.x = pk2(o4.x, o4.y); o.y = pk2(o4.z, o4.w);
            *(u32x2*)(Kb + (size_t)(8 * it + q) * 256 + 4 * lane) = o; }
    }
}

#define XB_TMO      128
#define XB_XCNT(j)  (256  + 64 * (j))
#define XB_XSUB(j)  (1280 + 64 * (j))
#define XB_XGEN(j)  (2304 + 64 * (j))
#define XB_TOP      3328
#define XB_TOPGEN   3392
#define XCD_BAR_WORDS 3456
#define XB_SPIN_CAP (1u << 18)

__device__ __forceinline__ unsigned xb_ld(unsigned* p)              { return __hip_atomic_load(p, __ATOMIC_RELAXED, __HIP_MEMORY_SCOPE_AGENT); }
__device__ __forceinline__ unsigned xb_add(unsigned* p, unsigned v) { return __hip_atomic_fetch_add(p, v, __ATOMIC_RELAXED, __HIP_MEMORY_SCOPE_AGENT); }
__device__ __forceinline__ unsigned xb_xcc_id() { return (unsigned)__builtin_amdgcn_s_getreg((3 << 11) | 20) & 0xFu; }
#define XB_SPIN(cond, bar) do { unsigned _sp = 0; while (cond) { __builtin_amdgcn_s_sleep(1); \
    if ((++_sp & 255u) == 0u) { if (xb_ld(&(bar)[XB_TMO])) break; if (_sp > XB_SPIN_CAP) { atomicAdd(&(bar)[XB_TMO], 1u); break; } } } } while (0)

struct XcdBarrier {
    unsigned* bar; unsigned x;
    volatile LAS unsigned* st;
};

__device__ __forceinline__ XcdBarrier xcd_barrier_post(unsigned* bar, volatile LAS unsigned* st) {
    XcdBarrier b; b.bar = bar; b.x = xb_xcc_id(); b.st = st;
    if (threadIdx.x == 0) (void)xb_add(&bar[XB_XCNT(b.x)], 1u);
    return b;
}
__device__ __forceinline__ void xcd_barrier_complete(unsigned* bar, unsigned x, unsigned& nloc, unsigned& nx) {
    const unsigned G = gridDim.x * gridDim.y * gridDim.z;
    unsigned sum, cnt, mine, sp = 0u;
    for (;;) {
        sum = 0u; cnt = 0u; mine = 0u;
#pragma unroll
        for (unsigned j = 0; j < 16; ++j) { const unsigned c = xb_ld(&bar[XB_XCNT(j)]); sum += c; cnt += (c > 0u) ? 1u : 0u; mine = (j == x) ? c : mine; }
        if (sum == G) break;
        __builtin_amdgcn_s_sleep(1);
        if ((++sp & 255u) == 0u) { if (xb_ld(&bar[XB_TMO])) break; if (sp > XB_SPIN_CAP) { atomicAdd(&bar[XB_TMO], 1u); break; } }
    }
    nloc = mine > 0u ? mine : 1u; nx = cnt > 0u ? cnt : 1u;
}

__device__ __forceinline__ void xcd_barrier(const XcdBarrier& b) {
    asm volatile("s_waitcnt vmcnt(0)" ::: "memory");
    __syncthreads();
    if (threadIdx.x == 0) {
        unsigned* bar = b.bar;
        __builtin_amdgcn_s_waitcnt(0);
        unsigned nloc = b.st[0], nx = b.st[1];
        if (nloc == 0u) { xcd_barrier_complete(bar, b.x, nloc, nx); b.st[0] = nloc; b.st[1] = nx; }
        const unsigned old = xb_add(&bar[XB_XSUB(b.x)], 1u);
        const unsigned gen = old / nloc;
        if (old + 1u == (gen + 1u) * nloc) {
            __builtin_amdgcn_fence(__ATOMIC_RELEASE, "agent");
            asm volatile("s_waitcnt vmcnt(0)" ::: "memory");
            const unsigned og = xb_add(&bar[XB_TOP], 1u);
            const unsigned tg = og / nx;
            if (og + 1u == (tg + 1u) * nx) xb_add(&bar[XB_TOPGEN], 1u);
            else XB_SPIN(xb_ld(&bar[XB_TOPGEN]) == tg, bar);
            __builtin_amdgcn_fence(__ATOMIC_ACQUIRE, "agent");
            xb_add(&bar[XB_XGEN(b.x)], 1u);
            asm volatile("s_waitcnt vmcnt(0)" ::: "memory");
        } else {
            XB_SPIN(xb_ld(&bar[XB_XGEN(b.x)]) == gen, bar);
            __builtin_amdgcn_fence(__ATOMIC_ACQUIRE, "agent");
            asm volatile("s_waitcnt vmcnt(0)" ::: "memory");
        }
    }
    __syncthreads();
}

__global__ void __launch_bounds__(NTHR, 2) fwd_megakernel(KArgs a) {
    extern __shared__ __attribute__((aligned(16))) unsigned char lds_raw[];
    LAS unsigned char* lds = (LAS unsigned char*)lds_raw;
    __builtin_assume(__builtin_amdgcn_workitem_id_y() == 0); __builtin_assume(__builtin_amdgcn_workitem_id_z() == 0);
    cg::grid_group grid = cg::this_grid();
    const int tid = threadIdx.x, lane = tid & 63, wave = __builtin_amdgcn_readfirstlane(tid >> 6);
    unsigned char* ws = a.ws;
    const int lo = a.ph_lo, hi = a.ph_hi;
    const float* mods0 = (const float*)(ws + WS_MODS); const float* mods1 = mods0 + 3 * MODW;
    bf16r* AY = (bf16r*)(ws + WS_AY); bf16r* HB = (bf16r*)(ws + WS_H);
    volatile LAS unsigned* MISC = (volatile LAS unsigned*)(lds + RING_BYTES + 64);
    if (tid < 2) MISC[tid] = 0u;
    __syncthreads();
    XcdBarrier bar = xcd_barrier_post((unsigned*)(ws + WS_CTL) + 4096, MISC);
#define IN(k) (lo <= (k) && (k) < hi)
#define SEAM(k) do { if (IN(k) && IN((k) + 1)) xcd_barrier(bar); } while (0)
    if (hi < 0) grid.sync();

    if (IN(0)) { phase0(a, lds, tid, lane, wave); } SEAM(0);
    if (IN(1)) { phase_diff(a, lane, wave); } SEAM(1);
    if (IN(2)) {
        pg8::Gemm g{(const pg8::bf16_t*)(ws + WS_DIFF), (const pg8::bf16_t*)(ws + WS_WPOOL), MALL, DM, 256, DM, 256, 1, 1 << 20, 256 * 2, 0}; pg8::StaticOrder S; S.init(MALL, DM, gridDim.x, blockIdx.x);
        pg8::EpiStore<0> E{AY, DM, nullptr};
        pg8::gemm_phase<pg8::EpiStore<0>, pg8::StaticOrder, true, true>(lds, g, S, E);
    } SEAM(2);
    if (IN(3)) { phase_rows<true, true>(a, 0, MLAT, 8, mods0, 2, a.g_mix_post, mods0, 3, a.g_mlp_pre, lane, wave); phase_rows<true, true>(a, MLAT, MCTX, 2, mods0, 2, a.g_mix_post, mods0, 3, a.g_mlp_pre, lane, wave); } SEAM(3);
    if (IN(4)) {
        pg8::Gemm g{AY, (const pg8::bf16_t*)(ws + WS_WIN0), MALL, FF, DM, DM, DM, 1, 1 << 20, 0, 0}; pg8::StaticOrder S; S.init(MALL, FF, gridDim.x, blockIdx.x);
        pg8::EpiStore<1> E{HB, FF, nullptr};
        pg8::gemm_phase<pg8::EpiStore<1>, pg8::StaticOrder, true, true>(lds, g, S, E);
        { const bool many = gridDim.x > 64; __syncthreads();
          if (!(many && blockIdx.x < 32)) convert_weights(a, lds, wave, lane, many ? ((int)blockIdx.x - 32) * NWAVES + wave : (int)blockIdx.x * NWAVES + wave, many ? ((int)gridDim.x - 32) * NWAVES : (int)gridDim.x * NWAVES, true); }
    } SEAM(4);
    if (IN(5)) {
        pg8::Gemm g{HB, (const pg8::bf16_t*)(ws + WS_WOUT0), MLAT, DM, FF, FF, FF, 1, 1 << 20, 0, 0}; pg8::StaticOrder S; S.init(MLAT, DM, gridDim.x, blockIdx.x);
        pg8::EpiStore<0> E{AY, DM, nullptr};
        pg8::gemm_phase<pg8::EpiStore<0>, pg8::StaticOrder, true, true>(lds, g, S, E);
        pg8::Gemm g2{HB + (size_t)MLAT * FF, (const pg8::bf16_t*)(ws + WS_WOUT0), MCTX, DM * KSPLIT, FF / KSPLIT, FF, FF, 4, 4, (size_t)(FF / KSPLIT) * 2, (size_t)(FF / KSPLIT) * 2};
        pg8::StaticOrder S2; S2.init(MCTX, DM * KSPLIT, gridDim.x, blockIdx.x);
        pg8::EpiPart E2{a.out};
        pg8::gemm_phase<pg8::EpiPart, pg8::StaticOrder, true, true>(lds, g2, S2, E2);
    } SEAM(5);
    if (IN(6)) { phase_rows<false, true, true>(a, 0, MLAT, 8, mods0, 5, a.g_mlp_post, mods1, 0, a.g_mix_pre + DM, lane, wave); phase_rows<false, true, true>(a, MLAT, MCTX, 2, mods0, 5, a.g_mlp_post, mods1, 0, a.g_mix_pre + DM, lane, wave); } SEAM(6);
    if (IN(7)) {
        pg8::Gemm g{AY, (const pg8::bf16_t*)(ws + WS_WQKV), MALL, NQKV, DM, DM, DM, 1, 1 << 20, 0, 0}; pg8::StaticOrder S; S.init(MALL, NQKV, gridDim.x, blockIdx.x);
        pg8::EpiQKV E{(pg8::bf16_t*)(ws + WS_Q), (pg8::bf16_t*)(ws + WS_K), (pg8::bf16_t*)(ws + WS_V), SKV, SEQ / 256, a.g_k, (const float*)(ws + WS_ROPE), (const float*)(ws + WS_ROPE) + 4096, (LAS float*)(lds + RING_BYTES + 1024), EPS};
        pg8::gemm_phase<pg8::EpiQKV, pg8::StaticOrder, true, true>(lds, g, S, E);
    } SEAM(7);
    if (IN(9)) {
        const int G = gridDim.x, bx = blockIdx.x; const int vcu = (G % 8 == 0) ? (bx % 8) * (G / 8) + bx / 8 : bx;
        const int upb = (512 + G - 1) / G;
        const att::bf16* Q = (const att::bf16*)(ws + WS_Q); const att::bf16* Kb = (const att::bf16*)(ws + WS_K); const att::bf16* Vb = (const att::bf16*)(ws + WS_V); att::bf16* O = (att::bf16*)(ws + WS_O);
        float gqm = fmaxf(fabsf(a.g_q[lane]), fabsf(a.g_q[lane + 64])), gkm = fmaxf(fabsf(a.g_k[lane]), fabsf(a.g_k[lane + 64]));
#pragma unroll
        for (int o = 1; o < 64; o <<= 1) { gqm = fmaxf(gqm, __shfl_xor(gqm, o)); gkm = fmaxf(gkm, __shfl_xor(gkm, o)); }
        const float mC = __uint_as_float(__builtin_amdgcn_readfirstlane(__float_as_uint(128.0f * gqm * gkm * (att::SCALE * 1.4426950408889634f))));
        for (int i = 0; i < upb; ++i) {
            const int unit = vcu * upb + i; if (unit >= 512) break;
            const int grp = unit >> 7, rem = unit & 127, gq = rem >> 5, qb = rem & 31, b = grp >> 1, kvh = grp & 1, h = kvh * 4 + gq;
            const size_t qoff = ((size_t)(b * SEQ + qb * 256)) * DM + h * 128, koff = (size_t)b * SKV * 256 + kvh * 128;
            att::attn_dense_body<att::bf16>(Q + qoff, Kb + koff, Vb + koff, O + qoff, SKV, (char*)lds_raw, mC, a.g_q, (const float*)(ws + WS_ROPE), (const float*)(ws + WS_ROPE) + 4096, qb * 256);
            __syncthreads();
        }
    } SEAM(9);
    if (IN(10)) {
        pg8::Gemm g{(const pg8::bf16_t*)(ws + WS_O), (const pg8::bf16_t*)(ws + WS_WO), MLAT, DM, DM, DM, DM, 1, 1 << 20, 0, 0}; pg8::StaticOrder S; S.init(MLAT, DM, gridDim.x, blockIdx.x);
        pg8::EpiStore<0> E{AY, DM, nullptr};
        pg8::gemm_phase<pg8::EpiStore<0>, pg8::StaticOrder, true, true>(lds, g, S, E);
    } SEAM(10);
    if (IN(11)) { phase_rows<false, true>(a, 0, MLAT, 8, mods1, 2, a.g_mix_post + DM, mods1, 3, a.g_mlp_pre + DM, lane, wave); } SEAM(11);
    if (IN(12)) {
        pg8::Gemm g{AY, (const pg8::bf16_t*)(ws + WS_WIN1), MLAT, FF, DM, DM, DM, 1, 1 << 20, 0, 0}; pg8::StaticOrder S; S.init(MLAT, FF, gridDim.x, blockIdx.x);
        pg8::EpiStore<1> E{HB, FF, nullptr};
        pg8::gemm_phase<pg8::EpiStore<1>, pg8::StaticOrder, true, true>(lds, g, S, E);
    } SEAM(12);
    if (IN(13)) {
        pg8::Gemm g{HB, (const pg8::bf16_t*)(ws + WS_WOUT1), MLAT, DM, FF, FF, FF, 1, 1 << 20, 0, 0}; pg8::StaticOrder S; S.init(MLAT, DM, gridDim.x, blockIdx.x);
        pg8::EpiStore<0> E{AY, DM, nullptr};
        pg8::gemm_phase<pg8::EpiStore<0>, pg8::StaticOrder, true, true>(lds, g, S, E);
    } SEAM(13);
    if (IN(14)) { phase_rows<false, false>(a, 0, MLAT, 8, mods1, 5, a.g_mlp_post + DM, mods1, 0, a.g_mix_pre, lane, wave); }
#undef IN
#undef SEAM
}

#ifndef MK_MULTI
#define MK_MULTI 0
#endif
constexpr int NPHASES = 15;
extern "C" void kernel_launch(void* const* d_in, const int* in_sizes, int n_in, void* d_out, int out_size, void* d_ws, size_t ws_size, hipStream_t stream) {
    static int grid = 0;
    if (grid == 0) {
        if (n_in != 18 || in_sizes[0] != MLAT * DM || out_size != MLAT * DM || ws_size < WS_END) { fprintf(stderr, "kernel_launch: unexpected shapes (n_in %d in0 %d out %d ws %zu)\n", n_in, n_in > 0 ? in_sizes[0] : -1, out_size, ws_size); grid = -1; return; }
        int dev = 0, cus = 0, per_cu = 0;
        hipGetDevice(&dev); hipDeviceGetAttribute(&cus, hipDeviceAttributeMultiprocessorCount, dev);
        if (hipFuncSetAttribute((const void*)fwd_megakernel, hipFuncAttributeMaxDynamicSharedMemorySize, LDS_BYTES) != hipSuccess) { fprintf(stderr, "kernel_launch: hipFuncSetAttribute failed\n"); grid = -1; return; }
        if (hipOccupancyMaxActiveBlocksPerMultiprocessor(&per_cu, (const void*)fwd_megakernel, NTHR, LDS_BYTES) != hipSuccess || per_cu < 1) { fprintf(stderr, "kernel_launch: occupancy query says %d\n", per_cu); per_cu = 1; }
        (void)hipGetLastError();
        grid = cus * 1;
        fprintf(stderr, "kernel_launch: grid %d (cus %d, per_cu %d)\n", grid, cus, per_cu);
    }
    if (grid < 0) return;
    KArgs a{};
    const float** pp = (const float**)&a;
    for (int i = 0; i < 18; ++i) pp[i] = (const float*)d_in[i];
    a.out = (float*)d_out; a.ws = (unsigned char*)d_ws;
    if (hipMemsetAsync((char*)d_ws + WS_CTL, 0, WS_MODS + 192 * 1024, stream) != hipSuccess) { fprintf(stderr, "kernel_launch: memset of the control words failed\n"); return; }
#if MK_MULTI
    for (int p = 0; p < NPHASES; ++p) { a.ph_lo = p; a.ph_hi = p + 1;
        int reps = 1;
        if (MK_MULTI == 2 && (p == 2 || p == 4 || p == 5 || p == 7 || p == 10 || p == 12 || p == 13)) reps = 2;
        if (MK_MULTI == 3 && p == 9) reps = 2;
        if (MK_MULTI == 4 && (p == 0 || p == 1 || p == 8)) reps = 2;
        for (int r = 0; r < reps; ++r) hipLaunchKernelGGL(fwd_megakernel, dim3(grid), dim3(NTHR), LDS_BYTES, stream, a); }
#else
    a.ph_lo = 0; a.ph_hi = NPHASES;
    void* args[] = {&a};
    hipError_t e = hipLaunchCooperativeKernel((const void*)fwd_megakernel, dim3(grid), dim3(NTHR), args, LDS_BYTES, stream);
    if (e != hipSuccess) fprintf(stderr, "cooperative launch failed: %s (grid %d)\n", hipGetErrorString(e), grid);
#endif
}
```
